# Optimizing an MI355X kernel written in HIP

```python
import jax
import jax.numpy as jnp
from jax import lax
import numpy as np

D_MODEL = 1024
BATCH = 2
SEQ = 8192
DEPTH = 1

EPS = 1e-6
N_MOD = 6

GLA_HEADS = 4
GLA_DK = 64
GLA_DV = 128
GLA_KW = GLA_HEADS * GLA_DK
GLA_WIDTH = GLA_HEADS * GLA_DV
GLA_GATE_RANK = 16
GLA_GATE_NORM = 16.0
GLA_CHUNK = 16

SWA_HEADS = 8
SWA_KV_HEADS = 2
SWA_HD = 64
SWA_WIDTH = SWA_HEADS * SWA_HD
SWA_KVW = SWA_KV_HEADS * SWA_HD
WINDOW = 128
ROPE_THETA = 500000.0
ROPE_DIM = SWA_HD // 4

MIX_WIDTH = GLA_WIDTH + SWA_WIDTH
IN_SPLITS = (GLA_KW, GLA_KW, GLA_WIDTH, GLA_GATE_RANK, GLA_WIDTH, SWA_WIDTH, SWA_KVW, SWA_KVW)
IN_WIDTH = sum(IN_SPLITS)

N_EXPERTS = 256
TOP_K = 8
N_GROUPS = 8
TOPK_GROUPS = 4
EXPERT_FF = 256
SHARED_FF = 256
ROUTED_SCALE = 2.5
MOE_BLOCK = 128

kernel_name = 'hybrid_gla_swa_sink_moe_adaln_block'


def rmsnorm(x, g):
    xf = x.astype(jnp.float32)
    y = xf * lax.rsqrt(jnp.mean(xf * xf, axis=-1, keepdims=True) + EPS)
    return (y * g.astype(jnp.float32)).astype(x.dtype)


def split_cols(t, sizes):
    out, start = [], 0
    for s in sizes:
        out.append(t[..., start:start + s])
        start += s
    return out


def partial_rope(t, cos, sin):
    half = ROPE_DIM // 2
    t1 = t[..., :half]
    t2 = t[..., half:ROPE_DIM]
    cos = cos.astype(t.dtype)
    sin = sin.astype(t.dtype)
    return jnp.concatenate([t1 * cos - t2 * sin, t2 * cos + t1 * sin, t[..., ROPE_DIM:]], axis=-1)


def gla_heads(q, k, v, log_a):
    B, S = q.shape[0], q.shape[1]
    nc = S // GLA_CHUNK

    def chunks(t):
        return t.reshape(B, nc, GLA_CHUNK, GLA_HEADS, -1).transpose(0, 3, 1, 2, 4).astype(jnp.float32)

    qc = chunks(q) * (GLA_DK ** -0.5)
    kc = chunks(k)
    vc = chunks(v)
    b = jnp.cumsum(chunks(log_a), axis=3)
    b_last = b[:, :, :, -1:, :]

    causal = jnp.tril(jnp.ones((GLA_CHUNK, GLA_CHUNK), dtype=bool))
    diff = b[..., :, None, :] - b[..., None, :, :]
    decay = jnp.exp(jnp.where(causal[:, :, None], diff, -jnp.inf))
    attn = jnp.einsum('bhnid,bhnjd,bhnijd->bhnij', qc, kc, decay)
    o_intra = jnp.einsum('bhnij,bhnjv->bhniv', attn, vc)

    q_dec = jnp.moveaxis(qc * jnp.exp(b), 2, 0)
    k_dec = jnp.moveaxis(kc * jnp.exp(b_last - b), 2, 0)
    v_s = jnp.moveaxis(vc, 2, 0)
    chunk_decay = jnp.moveaxis(jnp.exp(b_last[:, :, :, 0, :]), 2, 0)

    def step(state, inp):
        qd, kd, vv, dec = inp
        o = jnp.einsum('bhid,bhdv->bhiv', qd, state)
        new_state = dec[..., None] * state + jnp.einsum('bhid,bhiv->bhdv', kd, vv)
        return new_state, o

    s0 = jnp.zeros((B, GLA_HEADS, GLA_DK, GLA_DV), jnp.float32)
    _, o_inter = lax.scan(step, s0, (q_dec, k_dec, v_s, chunk_decay))
    o = o_intra + jnp.moveaxis(o_inter, 0, 2)
    return o.transpose(0, 2, 3, 1, 4).reshape(B, S, GLA_HEADS, GLA_DV)


def swa_sink_heads(q, k, v, sinks):
    B, S = q.shape[0], q.shape[1]
    nb = S // WINDOW
    G = SWA_HEADS // SWA_KV_HEADS
    qb = q.reshape(B, nb, WINDOW, SWA_KV_HEADS, G, SWA_HD)

    def band(t):
        tp = jnp.pad(t, ((0, 0), (WINDOW, 0), (0, 0), (0, 0))).reshape(B, nb + 1, WINDOW, SWA_KV_HEADS, SWA_HD)
        return jnp.concatenate([tp[:, :-1], tp[:, 1:]], axis=2)

    kb = band(k)
    vb = band(v)
    s = jnp.einsum('bnqkgd,bnskd->bnkgqs', qb, kb).astype(jnp.float32) * (SWA_HD ** -0.5)
    qi = jnp.arange(WINDOW)[:, None]
    kj = jnp.arange(2 * WINDOW)[None, :]
    rel = qi + WINDOW - kj
    in_window = (rel >= 0) & (rel < WINDOW)
    key_exists = (jnp.arange(nb)[:, None, None] * WINDOW - WINDOW + kj[None]) >= 0
    mask = in_window[None] & key_exists
    s = jnp.where(mask[None, :, None, None], s, -jnp.inf)
    sink = sinks.astype(jnp.float32).reshape(SWA_KV_HEADS, G)[None, None, :, :, None, None]
    m = jnp.maximum(jnp.max(s, axis=-1, keepdims=True), sink)
    p = jnp.exp(s - m)
    p = p / (jnp.sum(p, axis=-1, keepdims=True) + jnp.exp(sink - m))
    o = jnp.einsum('bnkgqs,bnskd->bnqkgd', p.astype(v.dtype), vb)
    return o.reshape(B, S, SWA_WIDTH)


def route(xf, w_router, router_bias):
    N = xf.shape[0]
    scores = jax.nn.sigmoid(xf.astype(jnp.float32) @ w_router.astype(jnp.float32))
    sel = scores + router_bias.astype(jnp.float32)
    grp = sel.reshape(N, N_GROUPS, N_EXPERTS // N_GROUPS)
    grp_score = jnp.sum(lax.top_k(grp, 2)[0], axis=-1)
    _, gidx = lax.top_k(grp_score, TOPK_GROUPS)
    gmask = jnp.any(gidx[..., None] == jnp.arange(N_GROUPS), axis=1)
    sel = jnp.where(jnp.repeat(gmask, N_EXPERTS // N_GROUPS, axis=1), sel, -jnp.inf)
    _, idx = lax.top_k(sel, TOP_K)
    w = jnp.take_along_axis(scores, idx, axis=-1)
    w = w / jnp.sum(w, axis=-1, keepdims=True) * ROUTED_SCALE
    return idx, w


def routed_experts(xf, idx, w, w_gate, w_up, w_down):
    N, D = xf.shape
    A = N * TOP_K
    flat_e = idx.reshape(-1)
    order = jnp.argsort(flat_e)
    sorted_e = flat_e[order]
    tok = order // TOP_K
    counts = jnp.zeros((N_EXPERTS,), jnp.int32).at[flat_e].add(1)
    padded = (counts + MOE_BLOCK - 1) // MOE_BLOCK * MOE_BLOCK
    pad_end = jnp.cumsum(padded)
    pad_start = pad_end - padded
    start = jnp.cumsum(counts) - counts
    dest = pad_start[sorted_e] + jnp.arange(A) - start[sorted_e]
    n_blocks = (A + N_EXPERTS * (MOE_BLOCK - 1) + MOE_BLOCK - 1) // MOE_BLOCK
    rows = n_blocks * MOE_BLOCK
    xs = jnp.zeros((rows, D), xf.dtype).at[dest].set(xf[tok])
    block_e = jnp.minimum(jnp.searchsorted(pad_end, jnp.arange(n_blocks) * MOE_BLOCK, side='right'), N_EXPERTS - 1)

    def expert_block(args):
        xb, e = args
        h = jax.nn.silu(xb @ w_gate[e]) * (xb @ w_up[e])
        return h @ w_down[e]

    ys = lax.map(expert_block, (xs.reshape(n_blocks, MOE_BLOCK, D), block_e)).reshape(rows, D)
    contrib = ys[dest] * w.reshape(-1)[order][:, None].astype(ys.dtype)
    return jnp.zeros_like(xf).at[tok].add(contrib)


def setup_inputs(seed: int = 0) -> dict:
    key = jax.random.key(seed)
    ks = jax.random.split(key, 24)
    f32 = jnp.float32
    L, D = DEPTH, D_MODEL

    def nrm(k, shape, scale):
        return jax.random.normal(k, shape, f32) * scale

    x = jax.random.normal(ks[0], (BATCH, SEQ, D), f32)
    c = jax.random.normal(ks[1], (BATCH, D), f32)
    positions = jnp.broadcast_to(jnp.arange(SEQ, dtype=jnp.int32), (BATCH, SEQ))
    return {
        'x': x,
        'c': c,
        'positions': positions,
        'w_ada': nrm(ks[2], (L, D, N_MOD * D), 0.5 * D ** -0.5),
        'b_ada': nrm(ks[3], (L, N_MOD * D), 0.02),
        'g_attn': 1.0 + nrm(ks[4], (L, D), 0.02),
        'w_in': nrm(ks[5], (L, D, IN_WIDTH), D ** -0.5),
        'w_gk_up': nrm(ks[6], (L, GLA_GATE_RANK, GLA_KW), GLA_GATE_RANK ** -0.5),
        'b_gk': nrm(ks[7], (L, GLA_KW), 0.1),
        'g_gla_out': 1.0 + nrm(ks[8], (L, GLA_DV), 0.02),
        'sinks': nrm(ks[9], (L, SWA_HEADS), 0.5),
        'w_out': nrm(ks[10], (L, MIX_WIDTH, D), MIX_WIDTH ** -0.5),
        'g_ffn': 1.0 + nrm(ks[11], (L, D), 0.02),
        'w_router': nrm(ks[12], (L, D, N_EXPERTS), D ** -0.5),
        'router_bias': nrm(ks[13], (L, N_EXPERTS), 0.01),
        'w_gate': nrm(ks[14], (L, N_EXPERTS, D, EXPERT_FF), D ** -0.5),
        'w_up': nrm(ks[15], (L, N_EXPERTS, D, EXPERT_FF), D ** -0.5),
        'w_down': nrm(ks[16], (L, N_EXPERTS, EXPERT_FF, D), EXPERT_FF ** -0.5),
        'ws_gate': nrm(ks[17], (L, D, SHARED_FF), D ** -0.5),
        'ws_up': nrm(ks[18], (L, D, SHARED_FF), D ** -0.5),
        'ws_down': nrm(ks[19], (L, SHARED_FF, D), SHARED_FF ** -0.5),
        'g_final': 1.0 + nrm(ks[20], (D,), 0.02),
    }


def reference(x, c, positions, w_ada, b_ada, g_attn, w_in, w_gk_up, b_gk, g_gla_out, sinks, w_out,
              g_ffn, w_router, router_bias, w_gate, w_up, w_down, ws_gate, ws_up, ws_down, g_final):
    B, S, D = x.shape
    inv_freq = jnp.power(ROPE_THETA, -jnp.arange(0, ROPE_DIM, 2, dtype=jnp.float32) / ROPE_DIM)
    ang = positions.astype(jnp.float32)[..., None] * inv_freq
    cos = jnp.cos(ang)[:, :, None, :]
    sin = jnp.sin(ang)[:, :, None, :]
    c_act = jax.nn.silu(c)

    for l in range(DEPTH):
        mod = c_act @ w_ada[l] + b_ada[l]
        sh1, sc1, gt1, sh2, sc2, gt2 = jnp.split(mod, N_MOD, axis=-1)

        h = rmsnorm(x, g_attn[l]) * (1.0 + sc1[:, None]) + sh1[:, None]
        proj = h @ w_in[l]
        gq, gk, gv, g_low, g_r, sq, sk, sv = split_cols(proj, IN_SPLITS)

        log_a = jax.nn.log_sigmoid((g_low @ w_gk_up[l] + b_gk[l]).astype(jnp.float32)) / GLA_GATE_NORM
        o_gla = gla_heads(gq.reshape(B, S, GLA_HEADS, GLA_DK), gk.reshape(B, S, GLA_HEADS, GLA_DK),
                          gv.reshape(B, S, GLA_HEADS, GLA_DV), log_a.reshape(B, S, GLA_HEADS, GLA_DK))
        o_gla = rmsnorm(o_gla, g_gla_out[l]).astype(x.dtype)
        o_gla = (o_gla * jax.nn.silu(g_r.reshape(B, S, GLA_HEADS, GLA_DV))).reshape(B, S, GLA_WIDTH)

        q = partial_rope(sq.reshape(B, S, SWA_HEADS, SWA_HD), cos, sin)
        k = partial_rope(sk.reshape(B, S, SWA_KV_HEADS, SWA_HD), cos, sin)
        v = sv.reshape(B, S, SWA_KV_HEADS, SWA_HD)
        o_swa = swa_sink_heads(q, k, v, sinks[l])

        mixed = jnp.concatenate([o_gla, o_swa.astype(x.dtype)], axis=-1) @ w_out[l]
        x = x + gt1[:, None] * mixed

        h = rmsnorm(x, g_ffn[l]) * (1.0 + sc2[:, None]) + sh2[:, None]
        hf = h.reshape(B * S, D)
        shared = (jax.nn.silu(hf @ ws_gate[l]) * (hf @ ws_up[l])) @ ws_down[l]
        idx, wts = route(hf, w_router[l], router_bias[l])
        routed = routed_experts(hf, idx, wts, w_gate[l], w_up[l], w_down[l])
        x = x + gt2[:, None] * (shared + routed).reshape(B, S, D)

    return rmsnorm(x, g_final)
```

```cpp
#include <hip/hip_runtime.h>
#include <stdint.h>
#include <math.h>

namespace {
constexpr int D = 1024, NB = 2, S = 8192, M = NB * S;
constexpr int INW = 2320;
constexpr int C_GQ = 0, C_GK = 256, C_GV = 512, C_GLOW = 1024, C_GR = 1040, C_SQ = 1552, C_SK = 2064, C_SV = 2192;
constexpr int NE = 256, CAP = 16384, MAXT = (M * 8) / 64 + NE;
constexpr float EPS = 1e-6f;

template <class ARow, class Epi>
__device__ __forceinline__ void gemm_tile64(const ARow& arow, int mvalid, const float* __restrict__ Bm, int ldb, int n0, int nvalid, int K, const Epi& epi) {
    __shared__ float As[16][68];
    __shared__ float Bs[16][68];
    const int tid = threadIdx.x, tx = tid & 15, ty = tid >> 4;
    float acc[4][4];
#pragma unroll
    for (int i = 0; i < 4; ++i)
#pragma unroll
        for (int j = 0; j < 4; ++j) acc[i][j] = 0.f;
    const int ar = tid >> 2, akq = (tid & 3) * 4;
    const float* ap = (ar < mvalid) ? arow(ar) : nullptr;
    const int bk = tid >> 4, bnq = (tid & 15) * 4;
    for (int k0 = 0; k0 < K; k0 += 16) {
        float4 av = make_float4(0.f, 0.f, 0.f, 0.f);
        if (ap) av = *(const float4*)(ap + k0 + akq);
        As[akq + 0][ar] = av.x; As[akq + 1][ar] = av.y; As[akq + 2][ar] = av.z; As[akq + 3][ar] = av.w;
        float4 bv = make_float4(0.f, 0.f, 0.f, 0.f);
        if (bnq < nvalid) bv = *(const float4*)(Bm + (size_t)(k0 + bk) * ldb + n0 + bnq);
        *(float4*)&Bs[bk][bnq] = bv;
        __syncthreads();
#pragma unroll
        for (int k = 0; k < 16; ++k) {
            const float4 a = *(const float4*)&As[k][ty * 4];
            const float4 b = *(const float4*)&Bs[k][tx * 4];
            const float aa[4] = {a.x, a.y, a.z, a.w}, bb[4] = {b.x, b.y, b.z, b.w};
#pragma unroll
            for (int i = 0; i < 4; ++i)
#pragma unroll
                for (int j = 0; j < 4; ++j) acc[i][j] += aa[i] * bb[j];
        }
        __syncthreads();
    }
#pragma unroll
    for (int i = 0; i < 4; ++i)
#pragma unroll
        for (int j = 0; j < 4; ++j) {
            const int r = ty * 4 + i, c = tx * 4 + j;
            if (r < mvalid && c < nvalid) epi(r, n0 + c, acc[i][j]);
        }
}

__device__ __forceinline__ float siluf(float v) { return v / (1.f + expf(-v)); }

__global__ void k_mod(const float* c, const float* w_ada, const float* b_ada, float* mod) {
    const int n = blockIdx.x * blockDim.x + threadIdx.x, b = blockIdx.y;
    float acc = 0.f;
    for (int k = 0; k < D; ++k) acc += siluf(c[b * D + k]) * w_ada[(size_t)k * 6144 + n];
    mod[b * 6144 + n] = acc + b_ada[n];
}

__device__ __forceinline__ float block_sum256(float v) {
    __shared__ float red[4];
#pragma unroll
    for (int o = 32; o >= 1; o >>= 1) v += __shfl_xor(v, o);
    __syncthreads();
    if ((threadIdx.x & 63) == 0) red[threadIdx.x >> 6] = v;
    __syncthreads();
    return red[0] + red[1] + red[2] + red[3];
}
__global__ void __launch_bounds__(256) k_normmod(const float* x, const float* g, const float* mod, int sh_off, int sc_off, float* out) {
    const int row = blockIdx.x, b = row / S, c0 = threadIdx.x * 4;
    const float4 v = *(const float4*)(x + (size_t)row * D + c0);
    const float ss = block_sum256(v.x * v.x + v.y * v.y + v.z * v.z + v.w * v.w);
    const float r = rsqrtf(ss * (1.f / D) + EPS);
    const float* mb = mod + b * 6144;
    const float vv[4] = {v.x, v.y, v.z, v.w};
    float o[4];
#pragma unroll
    for (int i = 0; i < 4; ++i) o[i] = vv[i] * r * g[c0 + i] * (1.f + mb[sc_off + c0 + i]) + mb[sh_off + c0 + i];
    *(float4*)(out + (size_t)row * D + c0) = make_float4(o[0], o[1], o[2], o[3]);
}

struct RowDense { const float* A; int lda; __device__ const float* operator()(int r) const { return A + (size_t)r * lda; } };
struct EpiStore { float* C; int ldc; int row0; __device__ void operator()(int r, int c, float v) const { C[(size_t)(row0 + r) * ldc + c] = v; } };

__global__ void __launch_bounds__(256) k_gemm_store(const float* A, int lda, const float* Bm, int ldb, float* C, int ldc, int N, int K) {
    const int row0 = blockIdx.y * 64, n0 = blockIdx.x * 64;
    RowDense ar{A + (size_t)row0 * lda, lda};
    EpiStore ep{C, ldc, row0};
    gemm_tile64(ar, 64, Bm, ldb, n0, min(64, N - n0), K, ep);
}

__global__ void k_gate(const float* proj, const float* w_up, const float* b_gk, float* loga) {
    const size_t idx = (size_t)blockIdx.x * blockDim.x + threadIdx.x;
    const int n = (int)(idx & 255); const size_t row = idx >> 8;
    float z = b_gk[n];
#pragma unroll
    for (int k = 0; k < 16; ++k) z += proj[row * INW + C_GLOW + k] * w_up[k * 256 + n];
    const float ls = fminf(z, 0.f) - log1pf(expf(-fabsf(z)));
    loga[idx] = ls * (1.f / 16.f);
}

__global__ void __launch_bounds__(128) k_gla_rec(const float* proj, const float* loga, float* og) {
    const int b = blockIdx.x >> 2, h = blockIdx.x & 3, dv = threadIdx.x;
    __shared__ float sq[32][64], sk[32][64], sa[32][64], sv[32][128];
    float St[64];
#pragma unroll
    for (int d = 0; d < 64; ++d) St[d] = 0.f;
    for (int t0 = 0; t0 < S; t0 += 32) {
        for (int i = threadIdx.x; i < 2048; i += 128) {
            const int tt = i >> 6, d = i & 63; const size_t row = (size_t)b * S + t0 + tt;
            sq[tt][d] = proj[row * INW + C_GQ + h * 64 + d] * 0.125f;
            sk[tt][d] = proj[row * INW + C_GK + h * 64 + d];
            sa[tt][d] = expf(loga[row * 256 + h * 64 + d]);
        }
        for (int i = threadIdx.x; i < 4096; i += 128) {
            const int tt = i >> 7, d = i & 127; const size_t row = (size_t)b * S + t0 + tt;
            sv[tt][d] = proj[row * INW + C_GV + h * 128 + d];
        }
        __syncthreads();
        for (int tt = 0; tt < 32; ++tt) {
            const float v = sv[tt][dv];
            float o = 0.f;
#pragma unroll
            for (int d = 0; d < 64; ++d) { St[d] = sa[tt][d] * St[d] + sk[tt][d] * v; o += sq[tt][d] * St[d]; }
            og[((size_t)b * S + t0 + tt) * 512 + h * 128 + dv] = o;
        }
        __syncthreads();
    }
}
__global__ void __launch_bounds__(256) k_gla_out(const float* og, const float* proj, const float* g_out, float* omix) {
    const size_t w = ((size_t)blockIdx.x * 256 + threadIdx.x) >> 6; const int lane = threadIdx.x & 63;
    const size_t row = w >> 2; const int h = (int)(w & 3);
    const float a = og[row * 512 + h * 128 + lane], b = og[row * 512 + h * 128 + 64 + lane];
    float ss = a * a + b * b;
#pragma unroll
    for (int o = 32; o >= 1; o >>= 1) ss += __shfl_xor(ss, o);
    const float r = rsqrtf(ss * (1.f / 128.f) + EPS);
    const float ga = proj[row * INW + C_GR + h * 128 + lane], gb = proj[row * INW + C_GR + h * 128 + 64 + lane];
    omix[row * 1024 + h * 128 + lane] = a * r * g_out[lane] * siluf(ga);
    omix[row * 1024 + h * 128 + 64 + lane] = b * r * g_out[64 + lane] * siluf(gb);
}

__global__ void k_rope(const float* proj, const int* positions, float* qr, float* kr) {
    const size_t idx = (size_t)blockIdx.x * blockDim.x + threadIdx.x;
    const size_t row = idx / 640; const int c = (int)(idx % 640);
    const float* src = proj + row * INW + C_SQ;
    const int d = c & 63;
    float out;
    if (d < 16) {
        const int i = d & 7;
        const float inv_freq = powf(500000.0f, -(float)(2 * i) / 16.0f);
        const float ang = (float)positions[row] * inv_freq;
        const float cs = cosf(ang), sn = sinf(ang);
        const float t1 = src[c - d + i], t2 = src[c - d + 8 + i];
        out = (d < 8) ? (t1 * cs - t2 * sn) : (t2 * cs + t1 * sn);
    } else out = src[c];
    if (c < 512) qr[row * 512 + c] = out; else kr[row * 128 + (c - 512)] = out;
}

__global__ void __launch_bounds__(64) k_swa(const float* qr, const float* kr, const float* proj, const float* sinks, float* omix) {
    const int blk = blockIdx.x;
    const int tb = blk % (S / 64), h = (blk / (S / 64)) % 8, b = blk / (S / 64 * 8);
    const int t0 = tb * 64, t = t0 + threadIdx.x, kvh = h >> 2;
    float q[64], o[64];
    const float* qp = qr + ((size_t)b * S + t) * 512 + h * 64;
#pragma unroll
    for (int d = 0; d < 64; ++d) { q[d] = qp[d] * 0.125f; o[d] = 0.f; }
    float m = sinks[h], l = 1.f;
    const int jlo = max(0, t0 - 127);
    for (int j = jlo; j <= t0 + 63; ++j) {
        const float* kp = kr + ((size_t)b * S + j) * 128 + kvh * 64;
        const float* vp = proj + ((size_t)b * S + j) * INW + C_SV + kvh * 64;
        float s = 0.f;
#pragma unroll
        for (int d = 0; d < 64; ++d) s += q[d] * kp[d];
        const bool valid = (j <= t) && (j >= t - 127);
        if (!valid) s = -INFINITY;
        if (s > m) {
            const float sc = expf(m - s); l *= sc;
#pragma unroll
            for (int d = 0; d < 64; ++d) o[d] *= sc;
            m = s;
        }
        const float p = expf(s - m); l += p;
#pragma unroll
        for (int d = 0; d < 64; ++d) o[d] += p * vp[d];
    }
    const float il = 1.f / l;
    float* op = omix + ((size_t)b * S + t) * 1024 + 512 + h * 64;
#pragma unroll
    for (int d = 0; d < 64; ++d) op[d] = o[d] * il;
}

struct EpiResid { const float* x; const float* mod; int goff; float* out; int row0;
    __device__ void operator()(int r, int c, float v) const { const int row = row0 + r; out[(size_t)row * D + c] = x[(size_t)row * D + c] + mod[(row / S) * 6144 + goff + c] * v; } };
__global__ void __launch_bounds__(256) k_gemm_resid(const float* A, const float* Bm, const float* x, const float* mod, int goff, float* out) {
    const int row0 = blockIdx.y * 64, n0 = blockIdx.x * 64;
    RowDense ar{A + (size_t)row0 * D, D};
    EpiResid ep{x, mod, goff, out, row0};
    gemm_tile64(ar, 64, Bm, D, n0, 64, D, ep);
}

__global__ void __launch_bounds__(256) k_route(const float* logits, const float* rbias, int* cnt, int* list, float* wts) {
    const int t = (blockIdx.x * 256 + threadIdx.x) >> 6, lane = threadIdx.x & 63;
    const float4 lg = *(const float4*)(logits + (size_t)t * 256 + lane * 4);
    const float4 rb = *(const float4*)(rbias + lane * 4);
    float sc0 = 1.f / (1.f + expf(-lg.x)), sc1 = 1.f / (1.f + expf(-lg.y)), sc2 = 1.f / (1.f + expf(-lg.z)), sc3 = 1.f / (1.f + expf(-lg.w));
    float s0 = sc0 + rb.x, s1 = sc1 + rb.y, s2 = sc2 + rb.z, s3 = sc3 + rb.w;
    float m1 = fmaxf(s0, s1), m2 = fminf(s0, s1);
    { const float n1 = fmaxf(m1, s2), n2 = fmaxf(fminf(m1, s2), m2); m1 = n1; m2 = n2; }
    { const float n1 = fmaxf(m1, s3), n2 = fmaxf(fminf(m1, s3), m2); m1 = n1; m2 = n2; }
#pragma unroll
    for (int off = 1; off < 8; off <<= 1) {
        const float o1 = __shfl_xor(m1, off), o2 = __shfl_xor(m2, off);
        const float n1 = fmaxf(m1, o1), n2 = fmaxf(fminf(m1, o1), fmaxf(m2, o2)); m1 = n1; m2 = n2;
    }
    const float gs = m1 + m2; const int myg = lane >> 3;
    int rank = 0;
#pragma unroll
    for (int j = 0; j < 8; ++j) { const float gj = __shfl(gs, j * 8); rank += (gj > gs || (gj == gs && j < myg)) ? 1 : 0; }
    if (rank >= 4) { s0 = -INFINITY; s1 = -INFINITY; s2 = -INFINITY; s3 = -INFINITY; }
    float wsum = 0.f, my_s = 0.f; int my_e = 0;
#pragma unroll
    for (int k = 0; k < 8; ++k) {
        float bv = s0; int bi = 0;
        if (s1 > bv) { bv = s1; bi = 1; }
        if (s2 > bv) { bv = s2; bi = 2; }
        if (s3 > bv) { bv = s3; bi = 3; }
        float v = bv; int e = lane * 4 + bi;
#pragma unroll
        for (int off = 32; off >= 1; off >>= 1) {
            const float ov = __shfl_xor(v, off); const int oe = __shfl_xor(e, off);
            if (ov > v || (ov == v && oe < e)) { v = ov; e = oe; }
        }
        const int ei = e & 3;
        const float mysc = ei == 0 ? sc0 : ei == 1 ? sc1 : ei == 2 ? sc2 : sc3;
        const float scw = __shfl(mysc, e >> 2);
        if (lane == (e >> 2)) { if (ei == 0) s0 = -INFINITY; else if (ei == 1) s1 = -INFINITY; else if (ei == 2) s2 = -INFINITY; else s3 = -INFINITY; }
        if (lane == k) { my_e = e; my_s = scw; }
        wsum += scw;
    }
    if (lane < 8) {
        const float w = my_s / wsum * 2.5f;
        const int pos = atomicAdd(&cnt[my_e], 1);
        list[my_e * CAP + pos] = t * 8 + lane;
        wts[t * 8 + lane] = w;
    }
}
__global__ void k_offsets(const int* cnt, int* offs, int* toff) {
    if (threadIdx.x == 0 && blockIdx.x == 0) {
        int a = 0, b = 0;
        for (int e = 0; e < NE; ++e) { offs[e] = a; toff[e] = b; a += cnt[e]; b += (cnt[e] + 63) >> 6; }
        offs[NE] = a; toff[NE] = b;
    }
}

struct RowGather { const float* h; const int* lst; __device__ const float* operator()(int r) const { return h + (size_t)(lst[r] >> 3) * D; } };
struct EpiAct { float* G; int first; __device__ void operator()(int r, int c, float v) const { float* p = G + (size_t)r * 256 + c; if (first) *p = v; else *p = siluf(*p) * v; } };
__device__ __forceinline__ bool find_tile(const int* toff, int tile, int& e, int& tl) {
    if (tile >= toff[NE]) return false;
    int lo = 0, hi = NE;
    while (hi - lo > 1) { const int mid = (lo + hi) >> 1; if (toff[mid] <= tile) lo = mid; else hi = mid; }
    e = lo; tl = tile - toff[lo]; return true;
}
__global__ void __launch_bounds__(256) k_moe_gu(const float* h2, const float* w_gate, const float* w_up, const int* cnt, const int* offs, const int* toff, const int* list, float* gbuf) {
    int e, tl; if (!find_tile(toff, blockIdx.y, e, tl)) return;
    const int n0 = blockIdx.x * 64, mvalid = min(64, cnt[e] - tl * 64);
    RowGather ar{h2, list + (size_t)e * CAP + tl * 64};
    float* G = gbuf + (size_t)(offs[e] + tl * 64) * 256;
    gemm_tile64(ar, mvalid, w_gate + (size_t)e * D * 256, 256, n0, 64, D, EpiAct{G, 1});
    gemm_tile64(ar, mvalid, w_up + (size_t)e * D * 256, 256, n0, 64, D, EpiAct{G, 0});
}
struct EpiScatter { float* routed; const int* lst; const float* wts; __device__ void operator()(int r, int c, float v) const { const int en = lst[r]; atomicAdd(routed + (size_t)(en >> 3) * D + c, wts[en] * v); } };
__global__ void __launch_bounds__(256) k_moe_down(const float* gbuf, const float* w_down, const int* cnt, const int* offs, const int* toff, const int* list, const float* wts, float* routed) {
    int e, tl; if (!find_tile(toff, blockIdx.y, e, tl)) return;
    const int n0 = blockIdx.x * 64, mvalid = min(64, cnt[e] - tl * 64);
    RowDense ar{gbuf + (size_t)(offs[e] + tl * 64) * 256, 256};
    gemm_tile64(ar, mvalid, w_down + (size_t)e * 256 * D, D, n0, 64, 256, EpiScatter{routed, list + (size_t)e * CAP + tl * 64, wts});
}
__global__ void __launch_bounds__(256) k_sh_gu(const float* h2, const float* wg, const float* wu, float* sact) {
    const int row0 = blockIdx.y * 64, n0 = blockIdx.x * 64;
    RowDense ar{h2 + (size_t)row0 * D, D};
    float* G = sact + (size_t)row0 * 256;
    gemm_tile64(ar, 64, wg, 256, n0, 64, D, EpiAct{G, 1});
    gemm_tile64(ar, 64, wu, 256, n0, 64, D, EpiAct{G, 0});
}

__global__ void __launch_bounds__(256) k_final(const float* xmid, const float* ffn, const float* mod, const float* g, float* out) {
    const int row = blockIdx.x, b = row / S, c0 = threadIdx.x * 4;
    const float4 xv = *(const float4*)(xmid + (size_t)row * D + c0);
    const float4 fv = *(const float4*)(ffn + (size_t)row * D + c0);
    const float* gt = mod + b * 6144 + 5120 + c0;
    const float v[4] = {xv.x + gt[0] * fv.x, xv.y + gt[1] * fv.y, xv.z + gt[2] * fv.z, xv.w + gt[3] * fv.w};
    const float ss = block_sum256(v[0] * v[0] + v[1] * v[1] + v[2] * v[2] + v[3] * v[3]);
    const float r = rsqrtf(ss * (1.f / D) + EPS);
    *(float4*)(out + (size_t)row * D + c0) = make_float4(v[0] * r * g[c0], v[1] * r * g[c0 + 1], v[2] * r * g[c0 + 2], v[3] * r * g[c0 + 3]);
}
}

extern "C" void kernel_launch(void* const* d_in, const int* in_sizes, int n_in, void* d_out, int out_size, void* d_ws, size_t ws_size, hipStream_t stream) {
    const float* x = (const float*)d_in[0]; const float* c = (const float*)d_in[1]; const int* positions = (const int*)d_in[2];
    const float* w_ada = (const float*)d_in[3]; const float* b_ada = (const float*)d_in[4]; const float* g_attn = (const float*)d_in[5];
    const float* w_in = (const float*)d_in[6]; const float* w_gk_up = (const float*)d_in[7]; const float* b_gk = (const float*)d_in[8];
    const float* g_gla_out = (const float*)d_in[9]; const float* sinks = (const float*)d_in[10]; const float* w_out = (const float*)d_in[11];
    const float* g_ffn = (const float*)d_in[12]; const float* w_router = (const float*)d_in[13]; const float* router_bias = (const float*)d_in[14];
    const float* w_gate = (const float*)d_in[15]; const float* w_up = (const float*)d_in[16]; const float* w_down = (const float*)d_in[17];
    const float* ws_gate = (const float*)d_in[18]; const float* ws_up = (const float*)d_in[19]; const float* ws_down = (const float*)d_in[20];
    const float* g_final = (const float*)d_in[21];
    float* out = (float*)d_out;
    char* ws = (char*)d_ws; size_t off = 0;
    auto carve = [&](size_t bytes) { char* p = ws + off; off += (bytes + 255) & ~(size_t)255; return p; };
    int* cnt = (int*)carve(1024); int* offs = (int*)carve(2048); int* toff = (int*)carve(2048);
    float* mod = (float*)carve(2 * 6144 * 4);
    float* hbuf = (float*)carve((size_t)M * D * 4);
    float* proj = (float*)carve((size_t)M * INW * 4);
    float* loga = (float*)carve((size_t)M * 256 * 4);
    float* og = (float*)carve((size_t)M * 512 * 4);
    float* qr = (float*)carve((size_t)M * 512 * 4);
    float* kr = (float*)carve((size_t)M * 128 * 4);
    float* omix = (float*)carve((size_t)M * D * 4);
    float* xmid = (float*)carve((size_t)M * D * 4);
    float* logits = (float*)carve((size_t)M * 256 * 4);
    int* list = (int*)carve((size_t)NE * CAP * 4);
    float* wts = (float*)carve((size_t)M * 8 * 4);
    float* gbuf = (float*)carve((size_t)(M * 8 + 64) * 256 * 4);
    float* sact = (float*)carve((size_t)M * 256 * 4);
    float* ffn = (float*)carve((size_t)M * D * 4);
    if (off > ws_size) return;

    hipMemsetAsync(cnt, 0, 1024, stream);
    k_mod<<<dim3(6144 / 256, 2), 256, 0, stream>>>(c, w_ada, b_ada, mod);
    k_normmod<<<M, 256, 0, stream>>>(x, g_attn, mod, 0, 1024, hbuf);
    k_gemm_store<<<dim3((INW + 63) / 64, M / 64), 256, 0, stream>>>(hbuf, D, w_in, INW, proj, INW, INW, D);
    k_gate<<<(M * 256) / 256, 256, 0, stream>>>(proj, w_gk_up, b_gk, loga);
    k_gla_rec<<<8, 128, 0, stream>>>(proj, loga, og);
    k_gla_out<<<(M * 4 * 64) / 256, 256, 0, stream>>>(og, proj, g_gla_out, omix);
    k_rope<<<(int)(((size_t)M * 640) / 256), 256, 0, stream>>>(proj, positions, qr, kr);
    k_swa<<<NB * 8 * (S / 64), 64, 0, stream>>>(qr, kr, proj, sinks, omix);
    k_gemm_resid<<<dim3(D / 64, M / 64), 256, 0, stream>>>(omix, w_out, x, mod, 2048, xmid);
    k_normmod<<<M, 256, 0, stream>>>(xmid, g_ffn, mod, 3072, 4096, hbuf);
    k_gemm_store<<<dim3(256 / 64, M / 64), 256, 0, stream>>>(hbuf, D, w_router, 256, logits, 256, 256, D);
    k_route<<<M / 4, 256, 0, stream>>>(logits, router_bias, cnt, list, wts);
    k_offsets<<<1, 64, 0, stream>>>(cnt, offs, toff);
    k_sh_gu<<<dim3(4, M / 64), 256, 0, stream>>>(hbuf, ws_gate, ws_up, sact);
    k_gemm_store<<<dim3(D / 64, M / 64), 256, 0, stream>>>(sact, 256, ws_down, D, ffn, D, D, 256);
    k_moe_gu<<<dim3(4, MAXT), 256, 0, stream>>>(hbuf, w_gate, w_up, cnt, offs, toff, list, gbuf);
    k_moe_down<<<dim3(D / 64, MAXT), 256, 0, stream>>>(gbuf, w_down, cnt, offs, toff, list, wts, ffn);
    k_final<<<M, 256, 0, stream>>>(xmid, ffn, mod, g_final, out);
}
```

```cpp
#include <hip/hip_runtime.h>
#include <cstdio>
#include <cstdint>
#include <math.h>
namespace pg8 {
#define PG8_LAS __attribute__((address_space(3)))
typedef unsigned short bf16_t;
typedef short bf16x8 __attribute__((ext_vector_type(8)));
typedef float f32x4 __attribute__((ext_vector_type(4)));
typedef unsigned u32x4 __attribute__((ext_vector_type(4)));
constexpr int BM = 256, BK = 64, HALF = 128, HTB = HALF * BK * 2  , STAGE_BYTES = 8 * HTB, NXCD = 8, WGM = 8;

__host__ __device__ __forceinline__ int lds_byte(int r, int c) { const int st = (r >> 4) * 2 + (c >> 5), rr = r & 15, cc = c & 31, ob = rr * 64 + cc * 2; return st * 1024 + (ob ^ (((ob >> 9) & 1) << 5)); }
__host__ __device__ __forceinline__ void stage_rc(int b, int& R, int& C) { const int st = b / 1024, sb = b % 1024, swz = sb ^ (((sb >> 9) & 1) << 5); R = (st >> 1) * 16 + swz / 64; C = (st & 1) * 32 + (swz % 64) / 2; }
__host__ __device__ __forceinline__ int perm32(int rho) { const int n = rho >> 4, i = rho & 15; return 8 * (i >> 2) + 4 * n + (i & 3); }

struct Unit { int pm, pn; };
struct Gemm { const bf16_t* A; const bf16_t* Bt; int M, N, K; };

struct StaticOrder {
    int nM, nN, nwg, G, c;
    __host__ __device__ void init(int M, int N, int G_, int c_) { nM = M / BM; nN = N / BM; nwg = nM * nN; G = G_; c = c_; }
    __host__ __device__ bool next(int i, Unit& u) const {
        const long L = (long)i * G + c; if (L >= nwg) return false;
        int wgid = (int)L; { const int q = nwg / NXCD, r = nwg % NXCD, xcd = wgid % NXCD, off = wgid / NXCD; wgid = (xcd < r ? xcd * (q + 1) : r * (q + 1) + (xcd - r) * q) + off; }
        const int nig = WGM * nN, gid = wgid / nig, fm = gid * WGM, gsz = (nM - fm) < WGM ? (nM - fm) : WGM;
        u.pm = fm + ((wgid % nig) % gsz); u.pn = (wgid % nig) / gsz; return true;
    }
    __device__ __forceinline__ void a_ready(const Unit&) const {}
    __device__ __forceinline__ void done(const Unit&) const {}
};

__device__ __forceinline__ unsigned cvt_pk_bf16(float lo, float hi) { unsigned r; asm volatile("v_cvt_pk_bf16_f32 %0, %1, %2" : "=v"(r) : "v"(lo), "v"(hi)); return r; }
typedef float f32x2 __attribute__((ext_vector_type(2)));
__device__ __forceinline__ f32x2 gelu_pk(f32x2 v) {
    const f32x2 av = __builtin_elementwise_abs(v), d = av * 0.2316418882f + 1.0f;
    f32x2 t; t.x = __builtin_amdgcn_rcpf(d.x); t.y = __builtin_amdgcn_rcpf(d.y);
    f32x2 q = t * 0.5307027145f + (-0.7265760135f); q = q * t + 0.7107068705f; q = q * t + (-0.142248368f); q = q * t + 0.127414796f; q = q * t;
    const f32x2 s = (v * v) * (-0.72134752044f);
    f32x2 e; e.x = __builtin_amdgcn_exp2f(s.x); e.y = __builtin_amdgcn_exp2f(s.y);
    const f32x2 m = v * (q * e), r = v - m;
    f32x2 o; o.x = v.x < 0.f ? m.x : r.x; o.y = v.y < 0.f ? m.y : r.y; return o;
}

template <int ACT  > struct EpiBf16 {
    static constexpr bool PERM = true, AFTER_DRAIN = false; static_assert(ACT == 0 || ACT == 1, "EpiBf16: ACT is 0 (none) or 1 (gelu_pk)");
    bf16_t* O; int ldc; const float* bias; int split_cols; size_t split_stride; float scale0;
    __device__ __forceinline__ void operator()(const f32x4 (&acc)[2][2][4][2], const Unit& u, int wr, int wc, int fr, int fq) const {
        const int row0 = u.pm * BM + wr * 64 + fr; int colt = u.pn * BM; bf16_t* base = O;
        float sc = 1.f; if (split_cols) { const int t = colt / split_cols; base += (size_t)t * split_stride; colt -= t * split_cols; if (t == 0) sc = scale0; }
        const int col0 = colt + wc * 32 + 8 * fq, bcol0 = u.pn * BM + wc * 32 + 8 * fq;
        f32x4 bv[2][2];
#pragma unroll
        for (int bj = 0; bj < 2; ++bj)
#pragma unroll
            for (int n = 0; n < 2; ++n) bv[bj][n] = bias ? *(const f32x4*)(bias + bcol0 + bj * HALF + 4 * n) : (f32x4){0.f, 0.f, 0.f, 0.f};
#pragma unroll
        for (int ai = 0; ai < 2; ++ai)
#pragma unroll
            for (int m = 0; m < 4; ++m) { bf16_t* rowp = base + (size_t)(row0 + ai * HALF + m * 16) * ldc + col0;
#pragma unroll
                for (int bj = 0; bj < 2; ++bj) { f32x4 v0 = acc[ai][bj][m][0] + bv[bj][0], v1 = acc[ai][bj][m][1] + bv[bj][1];
                    if (ACT == 1) { f32x2 a = gelu_pk((f32x2){v0[0], v0[1]}), b = gelu_pk((f32x2){v0[2], v0[3]}), c = gelu_pk((f32x2){v1[0], v1[1]}), d = gelu_pk((f32x2){v1[2], v1[3]});
                        v0 = (f32x4){a.x, a.y, b.x, b.y}; v1 = (f32x4){c.x, c.y, d.x, d.y}; }
                    v0 = v0 * sc; v1 = v1 * sc; u32x4 w; w.x = cvt_pk_bf16(v0[0], v0[1]); w.y = cvt_pk_bf16(v0[2], v0[3]); w.z = cvt_pk_bf16(v1[0], v1[1]); w.w = cvt_pk_bf16(v1[2], v1[3]);
                    *(u32x4*)(rowp + bj * HALF) = w; } }
    }
};

struct PanelStats {
    unsigned* xbuf;
    unsigned* cnt;
    unsigned* tmo;
    int ntn; float eps;
    unsigned code;
    __device__ __forceinline__ bool run(const f32x4 (&v)[2][2][4][2], const Unit& u, int wr, int wc, int fr, int fq, PG8_LAS unsigned char* lds, int wid, int lane) const {
        typedef float f32x2v __attribute__((ext_vector_type(2)));
        PG8_LAS f32x2v* P = (PG8_LAS f32x2v*)lds;
        PG8_LAS f32x2v* S = (PG8_LAS f32x2v*)(lds + 8192);
        PG8_LAS unsigned* flag = (PG8_LAS unsigned*)(lds + 8192 + 2048);
#pragma unroll
        for (int ai = 0; ai < 2; ++ai)
#pragma unroll
            for (int m = 0; m < 4; ++m) {
                float s = 0.f;
#pragma unroll
                for (int bj = 0; bj < 2; ++bj)
#pragma unroll
                    for (int n = 0; n < 2; ++n) { const f32x4 x = v[ai][bj][m][n]; s += (x[0] + x[1]) + (x[2] + x[3]); }
                s += __shfl_xor(s, 16); s += __shfl_xor(s, 32);
                const float mw = s * (1.0f / 64.0f); float q = 0.f;
#pragma unroll
                for (int bj = 0; bj < 2; ++bj)
#pragma unroll
                    for (int n = 0; n < 2; ++n) { const f32x4 d = v[ai][bj][m][n] - mw; q += (d[0] * d[0] + d[1] * d[1]) + (d[2] * d[2] + d[3] * d[3]); }
                q += __shfl_xor(q, 16); q += __shfl_xor(q, 32);
                if (fq == 0) P[(ai * HALF + wr * 64 + m * 16 + fr) * 4 + wc] = (f32x2v){mw, q};
            }
        asm volatile("s_waitcnt lgkmcnt(0)" ::: "memory"); __builtin_amdgcn_s_barrier(); asm volatile("" ::: "memory");
#if defined(BROKEN_EXCHANGE_NO_WAIT)
#warning BROKEN CONTROL BUILD: the row-statistics exchange does not wait; results are wrong by design
        if (blockIdx.x >= 64) { const long long t0_ = clock64(); while (clock64() - t0_ < 60000) __builtin_amdgcn_s_sleep(8); }
#endif
        const int row = wid * 32 + (lane & 31);
        if (lane < 32) {
            const f32x2v a = P[row * 4 + 0], b = P[row * 4 + 1], c = P[row * 4 + 2], d = P[row * 4 + 3];
            const float mt = (a.x + b.x + c.x + d.x) * 0.25f;
            const float da = a.x - mt, db = b.x - mt, dc = c.x - mt, dd = d.x - mt;
            const float m2 = (a.y + b.y) + (c.y + d.y) + 64.0f * ((da * da + db * db) + (dc * dc + dd * dd));
            unsigned long long* slot = (unsigned long long*)xbuf + ((size_t)(u.pm * BM + row) * 4 + u.pn);
            __hip_atomic_store(slot, ((unsigned long long)__float_as_uint(m2) << 32) | __float_as_uint(mt), __ATOMIC_RELAXED, __HIP_MEMORY_SCOPE_AGENT);
        }
        asm volatile("s_waitcnt vmcnt(0)" ::: "memory");
        if (lane == 0) __hip_atomic_fetch_add(cnt + 64 * u.pm, 1u, __ATOMIC_RELAXED, __HIP_MEMORY_SCOPE_AGENT);
        if (wid == 0) {
            bool dead = false; const unsigned long long t0 = __builtin_amdgcn_s_memrealtime(); const unsigned want = 8u * (unsigned)ntn;
            for (;;) {
#if defined(BROKEN_EXCHANGE_NO_WAIT)
                break;
#endif
                if ((unsigned)__builtin_amdgcn_readfirstlane(__hip_atomic_load(cnt + 64 * u.pm, __ATOMIC_RELAXED, __HIP_MEMORY_SCOPE_AGENT)) >= want) break;
                if (__builtin_amdgcn_s_memrealtime() - t0 > 2000000ull) {
                    if (lane == 0) { unsigned expect = 0u; __hip_atomic_compare_exchange_strong(tmo + 1, &expect, code | (unsigned)(u.pm & 0xff), __ATOMIC_RELAXED, __ATOMIC_RELAXED, __HIP_MEMORY_SCOPE_AGENT);
                                     __hip_atomic_store(tmo, 1u, __ATOMIC_RELAXED, __HIP_MEMORY_SCOPE_AGENT); }
                    dead = true; break; }
                __builtin_amdgcn_s_sleep(2);
            }
            __builtin_amdgcn_fence(__ATOMIC_ACQUIRE, "agent");
            if (lane == 0) flag[0] = dead ? 1u : 0u;
        }
        asm volatile("s_waitcnt vmcnt(0) lgkmcnt(0)" ::: "memory"); __builtin_amdgcn_s_barrier(); asm volatile("" ::: "memory");
        const bool bad = flag[0] != 0u;
        if (lane < 32) {
            const unsigned long long* slot = (const unsigned long long*)xbuf + (size_t)(u.pm * BM + row) * 4; float mt[4], m2[4]; float ms = 0.f;
#pragma unroll
            for (int t = 0; t < 4; ++t) { if (t < ntn) { const unsigned long long w = __hip_atomic_load(slot + t, __ATOMIC_RELAXED, __HIP_MEMORY_SCOPE_AGENT); mt[t] = __uint_as_float((unsigned)w); m2[t] = __uint_as_float((unsigned)(w >> 32)); } else { mt[t] = 0.f; m2[t] = 0.f; } ms += mt[t]; }
            const float mean = ms / (float)ntn; float q = 0.f;
#pragma unroll
            for (int t = 0; t < 4; ++t) if (t < ntn) { const float dm = mt[t] - mean; q += m2[t] + 256.0f * dm * dm; }
            S[row] = (f32x2v){mean, 1.0f / sqrtf(q / (256.0f * (float)ntn) + eps)};
        }
        asm volatile("s_waitcnt lgkmcnt(0)" ::: "memory"); __builtin_amdgcn_s_barrier(); asm volatile("" ::: "memory");
        return bad;
    }
};

template <class Epi, class Sched, bool ALIGN_EPI = false, bool SP2 = false>
__device__ __forceinline__ void gemm_phase(PG8_LAS unsigned char* lds, const Gemm g, const Sched& S, const Epi& E) {
    const int tid = threadIdx.x, wid = __builtin_amdgcn_readfirstlane(tid >> 6), lane = tid & 63, wr = wid >> 2, wc = wid & 3, fr = lane & 15, fq = lane >> 4;
    const int K = g.K, nt = K / BK;
    unsigned voffA[2], voffB[2];
#pragma unroll
    for (int i = 0; i < 2; ++i) { int R, C; stage_rc(tid * 16 + i * 8192, R, C); const int Rb = Epi::PERM ? ((R & ~31) + perm32(R & 31)) : R;
        voffA[i] = (unsigned)(R * K + C) * 2u; voffB[i] = (unsigned)(Rb * K + C) * 2u; }
    const size_t kstep = (size_t)(BK * 2);
    const size_t hstep = (size_t)HALF * K * 2;
    const size_t tstep = 2 * hstep;
    const unsigned ldsw = (unsigned)wid * 1024u;
    const int aoff = lds_byte(wr * 64 + fr, fq * 8), boff = lds_byte(wc * 32 + fr, fq * 8);
#define PG8_SA(b, h) (((b) * 2 + (h)) * HTB)
#define PG8_SB(b, h) ((4 + (b) * 2 + (h)) * HTB)
#define PG8_STAGE(bufoff, gbase, voff) do { _Pragma("unroll") for (int _i = 0; _i < 2; ++_i) \
        __builtin_amdgcn_global_load_lds((const unsigned*)((const char*)(gbase) + (voff)[_i]), (PG8_LAS unsigned*)(lds + (bufoff) + ldsw + _i * 8192), 16, 0, 0); } while (0)
#define PG8_LDA(dst, b, h) do { _Pragma("unroll") for (int m = 0; m < 4; ++m) _Pragma("unroll") for (int k = 0; k < 2; ++k) dst[m][k] = *(const PG8_LAS bf16x8*)(lds + PG8_SA(b, h) + aoff + m * 2048 + k * 1024); } while (0)
#define PG8_LDB(dst, b, h) do { _Pragma("unroll") for (int n = 0; n < 2; ++n) _Pragma("unroll") for (int k = 0; k < 2; ++k) dst[n][k] = *(const PG8_LAS bf16x8*)(lds + PG8_SB(b, h) + boff + n * 2048 + k * 1024); } while (0)
#define PG8_MMA(ai, bj, At, Bt) do { __builtin_amdgcn_s_setprio(1); _Pragma("unroll") for (int m = 0; m < 4; ++m) _Pragma("unroll") for (int n = 0; n < 2; ++n) _Pragma("unroll") for (int k = 0; k < 2; ++k) \
        acc[ai][bj][m][n] = __builtin_amdgcn_mfma_f32_16x16x32_bf16(Bt[n][k], At[m][k], acc[ai][bj][m][n], 0, 0, 0); __builtin_amdgcn_s_setprio(0); } while (0)
#define PG8_WAIT_V(n) asm volatile("s_waitcnt vmcnt(" #n ")" ::: "memory")
#define PG8_WAIT_L(n) asm volatile("s_waitcnt lgkmcnt(" #n ")" ::: "memory")
#define PG8_BAR __builtin_amdgcn_s_barrier()
#define PG8_SCHED __builtin_amdgcn_sched_barrier(0)
    Unit cur, nxt; int ui = 0;
    if (!S.next(0, cur)) return;
    f32x4 acc[2][2][4][2];
#pragma unroll
    for (int a = 0; a < 2; ++a)
#pragma unroll
        for (int b = 0; b < 2; ++b)
#pragma unroll
            for (int m = 0; m < 4; ++m)
#pragma unroll
                for (int n = 0; n < 2; ++n) acc[a][b][m][n] = (f32x4){0.f, 0.f, 0.f, 0.f};
    bf16x8 At[4][2], B0[2][2], B1[2][2];
    const char* cA = (const char*)g.A + (size_t)cur.pm * tstep; const char* cB = (const char*)g.Bt + (size_t)cur.pn * tstep;
    S.a_ready(cur);
    if constexpr (SP2) {
        PG8_STAGE(PG8_SB(0, 0), cB, voffB); PG8_STAGE(PG8_SB(0, 1), cB + hstep, voffB); PG8_STAGE(PG8_SA(0, 0), cA, voffA); PG8_STAGE(PG8_SA(0, 1), cA + hstep, voffA);
        if (wr == 1) PG8_BAR;
        PG8_WAIT_V(2); PG8_BAR;
        PG8_STAGE(PG8_SB(1, 0), cB + kstep, voffB); PG8_STAGE(PG8_SA(1, 0), cA + kstep, voffA); PG8_STAGE(PG8_SB(1, 1), cB + hstep + kstep, voffB);
        PG8_WAIT_V(6); PG8_BAR;
    } else {
        PG8_STAGE(PG8_SB(0, 0), cB, voffB); PG8_STAGE(PG8_SA(0, 0), cA, voffA); PG8_STAGE(PG8_SB(0, 1), cB + hstep, voffB); PG8_STAGE(PG8_SA(0, 1), cA + hstep, voffA);
        if (wr == 1) PG8_BAR;
        PG8_WAIT_V(4); PG8_BAR;
        PG8_STAGE(PG8_SB(1, 0), cB + kstep, voffB); PG8_STAGE(PG8_SA(1, 0), cA + kstep, voffA); PG8_STAGE(PG8_SB(1, 1), cB + hstep + kstep, voffB);
        PG8_WAIT_V(6); PG8_BAR;
    }
    for (;;) {
        const bool has_next = S.next(ui + 1, nxt);
        const char* nA = has_next ? (const char*)g.A + (size_t)nxt.pm * tstep : cA; const char* nB = has_next ? (const char*)g.Bt + (size_t)nxt.pn * tstep : cB;
        for (int t = 0; t < nt; t += 2) {
            const bool last = (t == nt - 2);
            const char* a1 = cA + (size_t)(t + 1) * kstep;
            const char* a2 = last ? nA : cA + (size_t)(t + 2) * kstep; const char* b2 = last ? nB : cB + (size_t)(t + 2) * kstep;
            const char* a3 = a2 + kstep; const char* b3 = b2 + kstep;
            if (last && has_next) S.a_ready(nxt);
            if constexpr (SP2) {
            PG8_LDB(B0, 0, 0); PG8_LDB(B1, 0, 1); PG8_SCHED; PG8_LDA(At, 0, 0); PG8_STAGE(PG8_SA(1, 1), a1 + hstep, voffA);
            PG8_WAIT_V(8); PG8_WAIT_L(0); PG8_BAR; PG8_MMA(0, 0, At, B0); PG8_MMA(0, 1, At, B1); PG8_BAR; PG8_SCHED;
            PG8_LDA(At, 0, 1); PG8_STAGE(PG8_SB(0, 0), b2, voffB); PG8_STAGE(PG8_SB(0, 1), b2 + hstep, voffB); PG8_STAGE(PG8_SA(0, 0), a2, voffA);
            PG8_WAIT_V(8); PG8_WAIT_L(0); PG8_BAR; PG8_MMA(1, 0, At, B0); PG8_MMA(1, 1, At, B1); PG8_BAR; PG8_SCHED;
            PG8_LDB(B0, 1, 0); PG8_LDB(B1, 1, 1); PG8_SCHED; PG8_LDA(At, 1, 0); PG8_STAGE(PG8_SA(0, 1), a2 + hstep, voffA);
            PG8_WAIT_V(8); PG8_WAIT_L(0); PG8_BAR; PG8_MMA(0, 0, At, B0); PG8_MMA(0, 1, At, B1); PG8_BAR; PG8_SCHED;
            PG8_LDA(At, 1, 1); PG8_STAGE(PG8_SB(1, 0), b3, voffB); PG8_STAGE(PG8_SB(1, 1), b3 + hstep, voffB); PG8_STAGE(PG8_SA(1, 0), a3, voffA);
            PG8_WAIT_V(8); PG8_WAIT_L(0); PG8_BAR; PG8_MMA(1, 0, At, B0); PG8_MMA(1, 1, At, B1); PG8_BAR; PG8_SCHED;
            } else {
            PG8_LDB(B0, 0, 0); PG8_SCHED; PG8_LDA(At, 0, 0); PG8_STAGE(PG8_SA(1, 1), a1 + hstep, voffA);
            PG8_WAIT_L(8); PG8_BAR; PG8_WAIT_L(0); PG8_MMA(0, 0, At, B0); PG8_BAR; PG8_SCHED;
            PG8_LDB(B1, 0, 1); PG8_STAGE(PG8_SB(0, 0), b2, voffB);
            PG8_BAR; PG8_WAIT_L(0); PG8_MMA(0, 1, At, B1); PG8_BAR;
            PG8_LDA(At, 0, 1); PG8_STAGE(PG8_SA(0, 0), a2, voffA);
            PG8_BAR; PG8_WAIT_L(0); PG8_MMA(1, 0, At, B0); PG8_BAR; PG8_SCHED;
            PG8_STAGE(PG8_SB(0, 1), b2 + hstep, voffB);
            PG8_WAIT_V(6); PG8_BAR; PG8_MMA(1, 1, At, B1); PG8_BAR;
            PG8_LDB(B0, 1, 0); PG8_SCHED; PG8_LDA(At, 1, 0); PG8_STAGE(PG8_SA(0, 1), a2 + hstep, voffA);
            PG8_WAIT_L(8); PG8_BAR; PG8_WAIT_L(0); PG8_MMA(0, 0, At, B0); PG8_BAR; PG8_SCHED;
            PG8_LDB(B1, 1, 1); PG8_STAGE(PG8_SB(1, 0), b3, voffB);
            PG8_BAR; PG8_WAIT_L(0); PG8_MMA(0, 1, At, B1); PG8_BAR;
            PG8_LDA(At, 1, 1); PG8_STAGE(PG8_SA(1, 0), a3, voffA);
            PG8_BAR; PG8_WAIT_L(0); PG8_MMA(1, 0, At, B0); PG8_BAR; PG8_SCHED;
            PG8_STAGE(PG8_SB(1, 1), b3 + hstep, voffB);
            PG8_WAIT_V(6); PG8_BAR; PG8_MMA(1, 1, At, B1); PG8_BAR;
            }
        }
        if constexpr (ALIGN_EPI) { if (wr == 0) PG8_BAR; }
        if constexpr (!Epi::AFTER_DRAIN) { E(acc, cur, wr, wc, fr, fq); S.done(cur); }
        if (!has_next) break;
#pragma unroll
        for (int a = 0; a < 2; ++a)
#pragma unroll
            for (int b = 0; b < 2; ++b)
#pragma unroll
                for (int m = 0; m < 4; ++m)
#pragma unroll
                    for (int n = 0; n < 2; ++n) acc[a][b][m][n] = (f32x4){0.f, 0.f, 0.f, 0.f};
        cur = nxt; cA = nA; cB = nB; ++ui;
        if constexpr (ALIGN_EPI) { if (wr == 1) PG8_BAR; }
    }
    PG8_WAIT_V(0);
    if constexpr (!ALIGN_EPI) { if (wr == 0) PG8_BAR; }
    PG8_BAR;
    if constexpr (Epi::AFTER_DRAIN) { E.fused(acc, cur, wr, wc, fr, fq, lds, wid, lane); S.done(cur); }
#undef PG8_SA
#undef PG8_SB
#undef PG8_STAGE
#undef PG8_LDA
#undef PG8_LDB
#undef PG8_MMA
#undef PG8_WAIT_V
#undef PG8_WAIT_L
#undef PG8_BAR
#undef PG8_SCHED
}
}
#define GAS __attribute__((address_space(1)))
#define LAS __attribute__((address_space(3)))
typedef unsigned short bf16;
typedef unsigned v4u __attribute__((ext_vector_type(4)));
typedef float f32x4 __attribute__((ext_vector_type(4)));
typedef short bf16x8 __attribute__((ext_vector_type(8)));
typedef GAS unsigned gu32;
typedef GAS unsigned long long gu64;
#define RLX_AGENT __ATOMIC_RELAXED, __HIP_MEMORY_SCOPE_AGENT
#define LDS_WAIT() asm volatile("s_waitcnt lgkmcnt(0)" ::: "memory")
#define VM_WAIT() asm volatile("s_waitcnt vmcnt(0)" ::: "memory")
__device__ __forceinline__ unsigned long long rt() { return __builtin_amdgcn_s_memrealtime(); }
__device__ __forceinline__ unsigned f2bf(float f) { unsigned u = __builtin_bit_cast(unsigned, f); return (u + 0x7fffu + ((u >> 16) & 1u)) >> 16; }
__device__ __forceinline__ unsigned pk2(float lo, float hi) { return f2bf(lo) | (f2bf(hi) << 16); }

#define XB_TMO      128
#define XB_XCNT(j)  (256  + 64 * (j))
#define XB_XSUB(j)  (1280 + 64 * (j))
#define XB_XGEN(j)  (2304 + 64 * (j))
#define XB_TOP      3328
#define XB_TOPGEN   3392
#define XCD_BAR_WORDS 3456
#define XB_SPIN_CAP (1u << 18)

__device__ __forceinline__ unsigned xb_ld(unsigned* p)              { return __hip_atomic_load(p, __ATOMIC_RELAXED, __HIP_MEMORY_SCOPE_AGENT); }
__device__ __forceinline__ unsigned xb_add(unsigned* p, unsigned v) { return __hip_atomic_fetch_add(p, v, __ATOMIC_RELAXED, __HIP_MEMORY_SCOPE_AGENT); }
__device__ __forceinline__ unsigned xb_xcc_id() { return (unsigned)__builtin_amdgcn_s_getreg((3 << 11) | 20) & 0xFu; }
#define XB_SPIN(cond, bar) do { unsigned _sp = 0; while (cond) { __builtin_amdgcn_s_sleep(1); \
    if ((++_sp & 255u) == 0u) { if (xb_ld(&(bar)[XB_TMO])) break; if (_sp > XB_SPIN_CAP) { atomicAdd(&(bar)[XB_TMO], 1u); break; } } } } while (0)

struct XcdBarrier {
    unsigned* bar; unsigned x;
    volatile LAS unsigned* st;
};

__device__ __forceinline__ XcdBarrier xcd_barrier_post(unsigned* bar, volatile LAS unsigned* st) {
    XcdBarrier b; b.bar = bar; b.x = xb_xcc_id(); b.st = st;
    if (threadIdx.x == 0) (void)xb_add(&bar[XB_XCNT(b.x)], 1u);
    return b;
}
__device__ __forceinline__ void xcd_barrier_complete(unsigned* bar, unsigned x, unsigned& nloc, unsigned& nx) {
    const unsigned G = gridDim.x * gridDim.y * gridDim.z;
    unsigned sum, cnt, mine, sp = 0u;
    for (;;) {
        sum = 0u; cnt = 0u; mine = 0u;
#pragma unroll
        for (unsigned j = 0; j < 16; ++j) { const unsigned c = xb_ld(&bar[XB_XCNT(j)]); sum += c; cnt += (c > 0u) ? 1u : 0u; mine = (j == x) ? c : mine; }
        if (sum == G) break;
        __builtin_amdgcn_s_sleep(1);
        if ((++sp & 255u) == 0u) { if (xb_ld(&bar[XB_TMO])) break; if (sp > XB_SPIN_CAP) { atomicAdd(&bar[XB_TMO], 1u); break; } }
    }
    nloc = mine > 0u ? mine : 1u; nx = cnt > 0u ? cnt : 1u;
}

__device__ __forceinline__ void xcd_barrier(const XcdBarrier& b) {
    asm volatile("s_waitcnt vmcnt(0)" ::: "memory");
    __syncthreads();
    if (threadIdx.x == 0) {
        unsigned* bar = b.bar;
        __builtin_amdgcn_s_waitcnt(0);
        unsigned nloc = b.st[0], nx = b.st[1];
        if (nloc == 0u) { xcd_barrier_complete(bar, b.x, nloc, nx); b.st[0] = nloc; b.st[1] = nx; }
        const unsigned old = xb_add(&bar[XB_XSUB(b.x)], 1u);
        const unsigned gen = old / nloc;
        if (old + 1u == (gen + 1u) * nloc) {
            __builtin_amdgcn_fence(__ATOMIC_RELEASE, "agent");
            asm volatile("s_waitcnt vmcnt(0)" ::: "memory");
            const unsigned og = xb_add(&bar[XB_TOP], 1u);
            const unsigned tg = og / nx;
            if (og + 1u == (tg + 1u) * nx) xb_add(&bar[XB_TOPGEN], 1u);
            else XB_SPIN(xb_ld(&bar[XB_TOPGEN]) == tg, bar);
            __builtin_amdgcn_fence(__ATOMIC_ACQUIRE, "agent");
            xb_add(&bar[XB_XGEN(b.x)], 1u);
            asm volatile("s_waitcnt vmcnt(0)" ::: "memory");
        } else {
            XB_SPIN(xb_ld(&bar[XB_XGEN(b.x)]) == gen, bar);
            __builtin_amdgcn_fence(__ATOMIC_ACQUIRE, "agent");
            asm volatile("s_waitcnt vmcnt(0)" ::: "memory");
        }
    }
    __syncthreads();
}
constexpr int NWAVES = 8, NTHREADS = 512;
constexpr int M = 16384, D = 1024, SEQ = 8192, INW = 2320, N1 = 2560, NE = 256, CAP = 16384;
constexpr float EPS = 1e-6f, LOG2E = 1.4426950408889634f, QS = 0.125f * 1.4426950408889634f;
constexpr size_t MiB = 1u << 20;
constexpr size_t WS_CTL = 0, CTL_ZERO_BYTES = 1 * MiB;
constexpr size_t WS_MOD = 1 * MiB, WS_CS = 2 * MiB, WS_W1T = 4 * MiB, WS_WOT = 10 * MiB, WS_W4T = 12 * MiB, WS_WSDT = 14 * MiB;
constexpr size_t WS_XN = 16 * MiB, WS_GQ = 48 * MiB, WS_GK = 56 * MiB, WS_GV = 64 * MiB, WS_LA = 80 * MiB, WS_SGR = 96 * MiB, WS_SQ = 112 * MiB, WS_SK = 128 * MiB, WS_SV = 132 * MiB;
constexpr size_t WS_OMIX = 136 * MiB, WS_XMID = 168 * MiB, WS_H2 = 232 * MiB, WS_LOGITS = 264 * MiB, WS_SACT = 280 * MiB, WS_SHOUT = 288 * MiB;
constexpr size_t WS_LIST = 352 * MiB, WS_WTS = 368 * MiB, WS_ACT = 370 * MiB, WS_GST = 440 * MiB, WS_SLOTS = 480 * MiB, WS_XCH = 740 * MiB, WS_NAIVE = 744 * MiB;
constexpr int CW_TMO = 0, CW_CODE = 1, CW_BAR = 4096, CW_SEAM = 16384, SEAM_BANK = 128 * 64, CW_CNT = 49152, CW_OFFS = 49152 + 512, CW_TOFF = 49152 + 1024;
constexpr int RING_OFF = 0, RING_BYTES = 131072, LDSCTL_OFF = RING_BYTES, MISC_OFF = LDSCTL_OFF + 320, LDS_BYTES = 147456;

__device__ __forceinline__ float bf2f(unsigned short h) { return __uint_as_float((unsigned)h << 16); }
__device__ __forceinline__ float siluf(float v) { return v / (1.f + __expf(-v)); }
__device__ __forceinline__ float wave_sum(float v) {
#pragma unroll
    for (int o = 1; o < 64; o <<= 1) v += __shfl_xor(v, o);
    return v;
}

struct Frame {
    LAS unsigned char* lds;
    volatile LAS unsigned* MISC;
    gu32* ctl;
    int tid, lane, wave, vcu, G;
    unsigned char* ws;
};

__device__ __forceinline__ void tr_writeout(bf16* WT, int K, int dst_row, int k0, LAS float* scr, int lane) {
    LDS_WAIT(); asm volatile("" ::: "memory");
    const int c = lane & 7;
#pragma unroll
    for (int j = 0; j < 4; ++j) { const int n = (lane >> 3) + 8 * j; const LAS float* s = scr + (8 * c) * 33 + n;
        v4u o; o.x = pk2(s[0 * 33], s[1 * 33]); o.y = pk2(s[2 * 33], s[3 * 33]); o.z = pk2(s[4 * 33], s[5 * 33]); o.w = pk2(s[6 * 33], s[7 * 33]);
        *(GAS v4u*)(WT + (size_t)(dst_row + n) * K + k0 + 8 * c) = o; }
    LDS_WAIT(); asm volatile("" ::: "memory");
}
__device__ __forceinline__ void tr_item(const float* W, int ldw, int col0, bf16* WT, int K, int dst_row0, int kb, int nb, LAS float* scr, int lane) {
    const int k0 = 64 * kb, n0 = 32 * nb;
#pragma unroll 8
    for (int i = 0; i < 32; ++i) { const int kk = 2 * i + (lane >> 5); scr[kk * 33 + (lane & 31)] = W[(size_t)(k0 + kk) * ldw + col0 + n0 + (lane & 31)]; }
    tr_writeout(WT, K, dst_row0 + n0, k0, scr, lane);
}
__device__ __forceinline__ void fold_item(const float* w_in, const float* w_up, bf16* WT, int kb, int nb, LAS float* scr, int lane) {
    const int k0 = 64 * kb, n0 = 32 * nb, n = n0 + (lane & 31);
    float wu[16];
#pragma unroll
    for (int r = 0; r < 16; ++r) wu[r] = w_up[r * 256 + n];
    for (int i = 0; i < 32; ++i) { const int kk = 2 * i + (lane >> 5); const float* wi = w_in + (size_t)(k0 + kk) * INW + 1024; float a = 0.f;
#pragma unroll
        for (int r = 0; r < 16; ++r) a += wi[r] * wu[r];
        scr[kk * 33 + (lane & 31)] = a; }
    tr_writeout(WT, 1024, 1024 + n0, k0, scr, lane);
}

struct P0In { const float *c, *w_ada, *b_ada, *w_in, *w_gk_up, *w_out, *w_router, *ws_gate, *ws_up, *ws_down; const int* positions; };
__device__ __forceinline__ void p0a_prep(Frame& F, const P0In& I) {
    bf16* W1t = (bf16*)(F.ws + WS_W1T); bf16* Wot = (bf16*)(F.ws + WS_WOT); bf16* W4t = (bf16*)(F.ws + WS_W4T); bf16* Wsdt = (bf16*)(F.ws + WS_WSDT);
    float* mod = (float*)(F.ws + WS_MOD); float* CS = (float*)(F.ws + WS_CS);
    if (F.vcu < 96) {
        const int n0 = 64 * F.vcu; float a0 = 0.f, a1 = 0.f;
        const float* wp = I.w_ada + (size_t)(128 * F.wave) * 6144 + n0 + F.lane;
#pragma unroll 8
        for (int k = 0; k < 128; ++k) { const float wv = wp[(size_t)k * 6144]; const int kk = 128 * F.wave + k;
            a0 += siluf(I.c[kk]) * wv; a1 += siluf(I.c[1024 + kk]) * wv; }
        LAS float* red = (LAS float*)(F.lds + RING_OFF + F.wave * 16384 + 12288);
        red[F.lane] = a0; red[64 + F.lane] = a1;
        LDS_WAIT(); __syncthreads();
        if (F.wave == 0) { float s0 = 0.f, s1 = 0.f;
#pragma unroll
            for (int w = 0; w < 8; ++w) { const LAS float* r = (const LAS float*)(F.lds + RING_OFF + w * 16384 + 12288); s0 += r[F.lane]; s1 += r[64 + F.lane]; }
            mod[n0 + F.lane] = s0 + I.b_ada[n0 + F.lane]; mod[6144 + n0 + F.lane] = s1 + I.b_ada[n0 + F.lane]; }
    }
    LAS float* scr = (LAS float*)(F.lds + RING_OFF + F.wave * 16384);
    const int gw = F.vcu * NWAVES + F.wave, NGW = F.G * NWAVES;
    for (int it = gw; it < 2304; it += NGW) {
        int r = it;
        if (r < 512) { tr_item(I.w_in, INW, 0, W1t, 1024, 0, r / 32, r % 32, scr, F.lane); continue; } r -= 512;
        if (r < 640) { tr_item(I.w_in, INW, 1040, W1t, 1024, 1280, r / 40, r % 40, scr, F.lane); continue; } r -= 640;
        if (r < 128) { fold_item(I.w_in, I.w_gk_up, W1t, r / 8, r % 8, scr, F.lane); continue; } r -= 128;
        if (r < 512) { tr_item(I.w_out, 1024, 0, Wot, 1024, 0, r / 32, r % 32, scr, F.lane); continue; } r -= 512;
        if (r < 128) { tr_item(I.w_router, 256, 0, W4t, 1024, 0, r / 8, r % 8, scr, F.lane); continue; } r -= 128;
        if (r < 64) { tr_item(I.ws_gate, 256, 0, W4t, 1024, 256, r / 4, r % 4, scr, F.lane); continue; } r -= 64;
        if (r < 64) { tr_item(I.ws_up, 256, 0, W4t, 1024, 384, r / 4, r % 4, scr, F.lane); continue; } r -= 64;
        if (r < 64) { tr_item(I.ws_gate, 256, 128, W4t, 1024, 512, r / 4, r % 4, scr, F.lane); continue; } r -= 64;
        if (r < 64) { tr_item(I.ws_up, 256, 128, W4t, 1024, 640, r / 4, r % 4, scr, F.lane); continue; } r -= 64;
        tr_item(I.ws_down, 1024, 0, Wsdt, 256, 0, r / 32, r % 32, scr, F.lane);
    }
    for (int idx = F.vcu * NTHREADS + F.tid; idx < M * 8; idx += F.G * NTHREADS) {
        const int row = idx >> 3, i = idx & 7;
        const float inv_freq = powf(500000.0f, -(float)(2 * i) / 16.0f);
        const float ang = (float)I.positions[row] * inv_freq;
        CS[row * 16 + i] = cosf(ang); CS[row * 16 + 8 + i] = sinf(ang);
    }
}

__device__ __forceinline__ void norm_rows(Frame& F, const float* x, const float* g, int sh_off, int sc_off, bf16* XN) {
    const float* mod = (const float*)(F.ws + WS_MOD);
    const int gw = F.vcu * NWAVES + F.wave, NGW = F.G * NWAVES;
    for (int m = gw; m < M; m += NGW) {
        const GAS f32x4* xr = (const GAS f32x4*)(x + (size_t)m * D) + F.lane;
        f32x4 v[4]; float s = 0.f;
#pragma unroll
        for (int j = 0; j < 4; ++j) { v[j] = xr[64 * j]; s += (v[j].x * v[j].x + v[j].y * v[j].y) + (v[j].z * v[j].z + v[j].w * v[j].w); }
        const float r = rsqrtf(wave_sum(s) * (1.f / D) + EPS);
        const float* mb = mod + (m >> 13) * 6144;
        GAS unsigned long long* o8 = (GAS unsigned long long*)(XN + (size_t)m * D) + F.lane;
#pragma unroll
        for (int j = 0; j < 4; ++j) { const int c = 4 * F.lane + 256 * j;
            const f32x4 gg = *(const f32x4*)(g + c), sc = *(const f32x4*)(mb + sc_off + c), sh = *(const f32x4*)(mb + sh_off + c);
            const f32x4 o = v[j] * r * gg * (sc + 1.0f) + sh;
            o8[64 * j] = (unsigned long long)pk2(o.x, o.y) | ((unsigned long long)pk2(o.z, o.w) << 32); }
    }
}

struct EpiP1 {
    static constexpr bool PERM = true, AFTER_DRAIN = false;
    unsigned char* ws; const float* b_gk;
    __device__ __forceinline__ void operator()(const pg8::f32x4 (&acc)[2][2][4][2], const pg8::Unit& u, int wr, int wc, int fr, int fq) const {
        const int row0 = u.pm * 256 + wr * 64 + fr, cl0 = wc * 32 + 8 * fq, pn = u.pn;
        if (pn == 4) {
            float* LA = (float*)(ws + WS_LA);
#pragma unroll
            for (int bj = 0; bj < 2; ++bj) {
                const int col = bj * 128 + cl0;
                const f32x4 b0 = *(const f32x4*)(b_gk + col), b1 = *(const f32x4*)(b_gk + col + 4);
#pragma unroll
                for (int ai = 0; ai < 2; ++ai)
#pragma unroll
                    for (int m = 0; m < 4; ++m) {
                        const f32x4 z0 = acc[ai][bj][m][0] + b0, z1 = acc[ai][bj][m][1] + b1; f32x4 o0, o1;
#pragma unroll
                        for (int i = 0; i < 4; ++i) { o0[i] = (fminf(z0[i], 0.f) - log1pf(__expf(-fabsf(z0[i])))) * 0.0625f; o1[i] = (fminf(z1[i], 0.f) - log1pf(__expf(-fabsf(z1[i])))) * 0.0625f; }
                        float* dst = LA + (size_t)(row0 + ai * 128 + m * 16) * 256 + col;
                        *(f32x4*)dst = o0; *(f32x4*)(dst + 4) = o1;
                    }
            }
            return;
        }
        size_t boff; int ld, bjs = 128, mode = 0; float scale = 1.f;
        if (pn == 0) { boff = WS_GQ; ld = 256; scale = 0.125f; }
        else if (pn == 1) { boff = WS_GK; ld = 256; }
        else if (pn < 4) { boff = WS_GV + (size_t)(pn - 2) * 512; ld = 512; }
        else if (pn < 7) { boff = WS_SGR + (size_t)(pn - 5) * 512; ld = 512; mode = 1; }
        else if (pn < 9) { boff = WS_SQ + (size_t)(pn - 7) * 512; ld = 512; mode = 2; scale = QS; }
        else { boff = WS_SK; ld = 128; bjs = (int)((WS_SV - WS_SK) / 2); mode = 3; }
        bf16* base = (bf16*)(ws + boff) + cl0;
        const bool ropewave = (mode >= 2) && ((wc & 1) == 0);
        const float* CS = (const float*)(ws + WS_CS);
#pragma unroll
        for (int ai = 0; ai < 2; ++ai)
#pragma unroll
            for (int m = 0; m < 4; ++m) {
                const int row = row0 + ai * 128 + m * 16;
                f32x4 cs0, cs1, sn0, sn1;
                if (ropewave) { const f32x4* cp = (const f32x4*)(CS + (size_t)row * 16); cs0 = cp[0]; cs1 = cp[1]; sn0 = cp[2]; sn1 = cp[3]; }
#pragma unroll
                for (int bj = 0; bj < 2; ++bj) {
                    f32x4 v0 = acc[ai][bj][m][0], v1 = acc[ai][bj][m][1];
                    if (mode == 1) {
#pragma unroll
                        for (int i = 0; i < 4; ++i) { v0[i] = siluf(v0[i]); v1[i] = siluf(v1[i]); }
                    }
                    if (ropewave && (mode == 2 || bj == 0)) {
                        f32x4 p0, p1;
#pragma unroll
                        for (int i = 0; i < 4; ++i) { p0[i] = __shfl_xor(v0[i], 16); p1[i] = __shfl_xor(v1[i], 16); }
                        if (fq == 0) { v0 = v0 * cs0 - p0 * sn0; v1 = v1 * cs1 - p1 * sn1; }
                        else if (fq == 1) { v0 = v0 * cs0 + p0 * sn0; v1 = v1 * cs1 + p1 * sn1; }
                    }
                    v0 = v0 * scale; v1 = v1 * scale;
                    pg8::u32x4 w; w.x = pg8::cvt_pk_bf16(v0[0], v0[1]); w.y = pg8::cvt_pk_bf16(v0[2], v0[3]); w.z = pg8::cvt_pk_bf16(v1[0], v1[1]); w.w = pg8::cvt_pk_bf16(v1[2], v1[3]);
                    *(pg8::u32x4*)(base + (size_t)row * ld + bj * bjs) = w;
                }
            }
    }
};
struct EpiXmid {
    static constexpr bool PERM = false, AFTER_DRAIN = false;
    const float* x; const float* mod; float* xmid;
    __device__ __forceinline__ void operator()(const pg8::f32x4 (&acc)[2][2][4][2], const pg8::Unit& u, int wr, int wc, int fr, int fq) const {
        const int row0 = u.pm * 256 + wr * 64 + fr, col0 = u.pn * 256 + wc * 32 + 4 * fq;
        const float* gt = mod + (u.pm >> 5) * 6144 + 2048;
        pg8::f32x4 gv[2][2];
#pragma unroll
        for (int bj = 0; bj < 2; ++bj)
#pragma unroll
            for (int n = 0; n < 2; ++n) gv[bj][n] = *(const pg8::f32x4*)(gt + col0 + bj * 128 + n * 16);
#pragma unroll
        for (int ai = 0; ai < 2; ++ai)
#pragma unroll
            for (int m = 0; m < 4; ++m) { const size_t off = (size_t)(row0 + ai * 128 + m * 16) * D + col0;
#pragma unroll
                for (int bj = 0; bj < 2; ++bj)
#pragma unroll
                    for (int n = 0; n < 2; ++n) { const pg8::f32x4 xv = *(const pg8::f32x4*)(x + off + bj * 128 + n * 16);
                        *(pg8::f32x4*)(xmid + off + bj * 128 + n * 16) = xv + gv[bj][n] * acc[ai][bj][m][n]; } }
    }
};
struct EpiP4 {
    static constexpr bool PERM = true, AFTER_DRAIN = false;
    float* logits; bf16* sact;
    __device__ __forceinline__ void operator()(const pg8::f32x4 (&acc)[2][2][4][2], const pg8::Unit& u, int wr, int wc, int fr, int fq) const {
        const int row0 = u.pm * 256 + wr * 64 + fr, cl0 = wc * 32 + 8 * fq;
#pragma unroll
        for (int ai = 0; ai < 2; ++ai)
#pragma unroll
            for (int m = 0; m < 4; ++m) { const int row = row0 + ai * 128 + m * 16;
                if (u.pn == 0) {
#pragma unroll
                    for (int bj = 0; bj < 2; ++bj) { float* dst = logits + (size_t)row * 256 + bj * 128 + cl0; *(pg8::f32x4*)dst = acc[ai][bj][m][0]; *(pg8::f32x4*)(dst + 4) = acc[ai][bj][m][1]; }
                } else {
                    pg8::f32x4 a0 = acc[ai][0][m][0], a1 = acc[ai][0][m][1]; const pg8::f32x4 u0 = acc[ai][1][m][0], u1 = acc[ai][1][m][1];
#pragma unroll
                    for (int i = 0; i < 4; ++i) { a0[i] = siluf(a0[i]) * u0[i]; a1[i] = siluf(a1[i]) * u1[i]; }
                    pg8::u32x4 w; w.x = pg8::cvt_pk_bf16(a0[0], a0[1]); w.y = pg8::cvt_pk_bf16(a0[2], a0[3]); w.z = pg8::cvt_pk_bf16(a1[0], a1[1]); w.w = pg8::cvt_pk_bf16(a1[2], a1[3]);
                    *(pg8::u32x4*)(sact + (size_t)row * 256 + (u.pn - 1) * 128 + cl0) = w;
                }
            }
    }
};
struct EpiF32x {
    static constexpr bool PERM = false, AFTER_DRAIN = false;
    float* C; int ldc;
    __device__ __forceinline__ void operator()(const pg8::f32x4 (&acc)[2][2][4][2], const pg8::Unit& u, int wr, int wc, int fr, int fq) const {
        const int row0 = u.pm * 256 + wr * 64 + fr, col0 = u.pn * 256 + wc * 32 + 4 * fq;
#pragma unroll
        for (int ai = 0; ai < 2; ++ai)
#pragma unroll
            for (int m = 0; m < 4; ++m) { float* rowp = C + (size_t)(row0 + ai * 128 + m * 16) * ldc + col0;
#pragma unroll
                for (int bj = 0; bj < 2; ++bj)
#pragma unroll
                    for (int n = 0; n < 2; ++n) *(pg8::f32x4*)(rowp + bj * 128 + n * 16) = acc[ai][bj][m][n]; }
    }
};

__device__ __forceinline__ void route_tokens(Frame& F, const float* logits, const float* rbias, int* cnt, int* list, float* wts) {
    const int gw = F.vcu * NWAVES + F.wave, NGW = F.G * NWAVES, lane = F.lane;
    const f32x4 rb = *(const f32x4*)(rbias + lane * 4);
    for (int t = gw; t < M; t += NGW) {
        const f32x4 lg = *(const f32x4*)(logits + (size_t)t * 256 + lane * 4);
        const float sc0 = 1.f / (1.f + expf(-lg.x)), sc1 = 1.f / (1.f + expf(-lg.y)), sc2 = 1.f / (1.f + expf(-lg.z)), sc3 = 1.f / (1.f + expf(-lg.w));
        float s0 = sc0 + rb.x, s1 = sc1 + rb.y, s2 = sc2 + rb.z, s3 = sc3 + rb.w;
        float m1 = fmaxf(s0, s1), m2 = fminf(s0, s1);
        { const float n1 = fmaxf(m1, s2), n2 = fmaxf(fminf(m1, s2), m2); m1 = n1; m2 = n2; }
        { const float n1 = fmaxf(m1, s3), n2 = fmaxf(fminf(m1, s3), m2); m1 = n1; m2 = n2; }
#pragma unroll
        for (int off = 1; off < 8; off <<= 1) {
            const float o1 = __shfl_xor(m1, off), o2 = __shfl_xor(m2, off);
            const float n1 = fmaxf(m1, o1), n2 = fmaxf(fminf(m1, o1), fmaxf(m2, o2)); m1 = n1; m2 = n2;
        }
        const float gs = m1 + m2; const int myg = lane >> 3;
        int rank = 0;
#pragma unroll
        for (int j = 0; j < 8; ++j) { const float gj = __shfl(gs, j * 8); rank += (gj > gs || (gj == gs && j < myg)) ? 1 : 0; }
        if (rank >= 4) { s0 = -INFINITY; s1 = -INFINITY; s2 = -INFINITY; s3 = -INFINITY; }
        float wsum = 0.f, my_s = 0.f; int my_e = 0;
#pragma unroll
        for (int k = 0; k < 8; ++k) {
            float bv = s0; int bi = 0;
            if (s1 > bv) { bv = s1; bi = 1; }
            if (s2 > bv) { bv = s2; bi = 2; }
            if (s3 > bv) { bv = s3; bi = 3; }
            float v = bv; int e = lane * 4 + bi;
#pragma unroll
            for (int off = 32; off >= 1; off >>= 1) {
                const float ov = __shfl_xor(v, off); const int oe = __shfl_xor(e, off);
                if (ov > v || (ov == v && oe < e)) { v = ov; e = oe; }
            }
            const int ei = e & 3;
            const float mysc = ei == 0 ? sc0 : ei == 1 ? sc1 : ei == 2 ? sc2 : sc3;
            const float scw = __shfl(mysc, e >> 2);
            if (lane == (e >> 2)) { if (ei == 0) s0 = -INFINITY; else if (ei == 1) s1 = -INFINITY; else if (ei == 2) s2 = -INFINITY; else s3 = -INFINITY; }
            if (lane == k) { my_e = e; my_s = scw; }
            wsum += scw;
        }
        if (lane < 8) {
            const float w = my_s / wsum * 2.5f;
            const int pos = atomicAdd(&cnt[my_e], 1);
            list[my_e * CAP + pos] = t * 8 + lane;
            wts[t * 8 + lane] = w;
        }
    }
}

__device__ __forceinline__ void final_rows(Frame& F, const float* xmid, const float* shout, const float* routed, const float* g, float* out) {
    const float* mod = (const float*)(F.ws + WS_MOD);
    const int gw = F.vcu * NWAVES + F.wave, NGW = F.G * NWAVES;
    for (int m = gw; m < M; m += NGW) {
        const size_t ro = (size_t)m * D;
        const float* gt = mod + (m >> 13) * 6144 + 5120;
        f32x4 v[4]; float s = 0.f;
#pragma unroll
        for (int j = 0; j < 4; ++j) { const int c = 4 * F.lane + 256 * j;
            const f32x4 xv = *(const f32x4*)(xmid + ro + c), sv = *(const f32x4*)(shout + ro + c), rv = *(const f32x4*)(routed + ro + c), gg = *(const f32x4*)(gt + c);
            v[j] = xv + gg * (sv + rv); s += (v[j].x * v[j].x + v[j].y * v[j].y) + (v[j].z * v[j].z + v[j].w * v[j].w); }
        const float r = rsqrtf(wave_sum(s) * (1.f / D) + EPS);
#pragma unroll
        for (int j = 0; j < 4; ++j) { const int c = 4 * F.lane + 256 * j; const f32x4 gf = *(const f32x4*)(g + c); *(f32x4*)(out + ro + c) = v[j] * r * gf; }
    }
}

struct RowBf16 { const bf16* base; const int* lst; int lda;
    __device__ __forceinline__ const bf16* operator()(int r) const { return base + (size_t)(lst ? (lst[r] >> 3) : r) * lda; } };
struct RowF32 { const float* base; int lda; __device__ __forceinline__ const float* operator()(int r) const { return base + (size_t)r * lda; } };
__device__ __forceinline__ f32x4 ld4(const float* p) { return *(const f32x4*)p; }
__device__ __forceinline__ f32x4 ld4(const bf16* p) { const unsigned long long w = *(const unsigned long long*)p;
    return (f32x4){bf2f((unsigned short)w), bf2f((unsigned short)(w >> 16)), bf2f((unsigned short)(w >> 32)), bf2f((unsigned short)(w >> 48))}; }
template <class ARow, class Epi>
__device__ __forceinline__ void fma_tile64(LAS unsigned char* ldsb, const ARow& arow, int mvalid, const float* __restrict__ Bm, int ldb, int n0, int K, const Epi& epi) {
    const int tid = threadIdx.x & 255, tx = tid & 15, ty = tid >> 4;
    LAS float* As = (LAS float*)(ldsb + (threadIdx.x >> 8) * 8704);
    LAS float* Bs = As + 16 * 68;
    float acc[4][4];
#pragma unroll
    for (int i = 0; i < 4; ++i)
#pragma unroll
        for (int j = 0; j < 4; ++j) acc[i][j] = 0.f;
    const int ar = tid >> 2, akq = (tid & 3) * 4, bk = tid >> 4, bnq = (tid & 15) * 4;
    const bool av_ok = ar < mvalid;
    for (int k0 = 0; k0 < K; k0 += 16) {
        f32x4 av = (f32x4){0.f, 0.f, 0.f, 0.f};
        if (av_ok) av = ld4(arow(ar) + k0 + akq);
        As[(akq + 0) * 68 + ar] = av.x; As[(akq + 1) * 68 + ar] = av.y; As[(akq + 2) * 68 + ar] = av.z; As[(akq + 3) * 68 + ar] = av.w;
        const f32x4 bv = *(const f32x4*)(Bm + (size_t)(k0 + bk) * ldb + n0 + bnq);
        *(LAS f32x4*)(Bs + bk * 68 + bnq) = bv;
        __syncthreads();
#pragma unroll
        for (int k = 0; k < 16; ++k) {
            const f32x4 a = *(const LAS f32x4*)(As + k * 68 + ty * 4);
            const f32x4 b = *(const LAS f32x4*)(Bs + k * 68 + tx * 4);
#pragma unroll
            for (int i = 0; i < 4; ++i)
#pragma unroll
                for (int j = 0; j < 4; ++j) acc[i][j] += a[i] * b[j];
        }
        __syncthreads();
    }
#pragma unroll
    for (int i = 0; i < 4; ++i)
#pragma unroll
        for (int j = 0; j < 4; ++j) { const int r = ty * 4 + i; if (r < mvalid) epi(r, n0 + tx * 4 + j, acc[i][j]); }
}
struct MoeMap { LAS int* cnt; LAS int* offs; LAS int* toff; };
__device__ __forceinline__ MoeMap moe_map_build(Frame& F, const int* cnt_g, int tile_rows) {
    MoeMap mm; mm.cnt = (LAS int*)(F.lds + RING_OFF + 2 * 8704); mm.offs = mm.cnt + 260; mm.toff = mm.offs + 260;
    if (F.tid < NE) mm.cnt[F.tid] = cnt_g[F.tid];
    LDS_WAIT(); __syncthreads();
    if (F.tid == 0) { int a = 0, b = 0; for (int e = 0; e < NE; ++e) { mm.offs[e] = a; mm.toff[e] = b; a += mm.cnt[e]; b += (mm.cnt[e] + tile_rows - 1) / tile_rows; } mm.offs[NE] = a; mm.toff[NE] = b; }
    LDS_WAIT(); __syncthreads();
    return mm;
}
__device__ __forceinline__ void moe_find(const MoeMap& mm, int tile, int& e, int& tl) {
    int lo = 0, hi = NE;
    while (hi - lo > 1) { const int mid = (lo + hi) >> 1; if (mm.toff[mid] <= tile) lo = mid; else hi = mid; }
    e = lo; tl = tile - mm.toff[lo];
}
struct EpiActF { float* G; int first; __device__ __forceinline__ void operator()(int r, int c, float v) const { float* p = G + (size_t)r * 256 + c; if (first) *p = v; else *p = siluf(*p) * v; } };
struct EpiScatterF { float* routed; const int* lst; const float* wts; __device__ __forceinline__ void operator()(int r, int c, float v) const { const int en = lst[r]; atomicAdd(routed + (size_t)(en >> 3) * D + c, wts[en] * v); } };
__device__ __forceinline__ void moe_simple_gu(Frame& F, const bf16* H2, const float* w_gate, const float* w_up, const int* cnt_g, const int* list, float* gbuf) {
    const MoeMap mm = moe_map_build(F, cnt_g, 64);
    const int ntiles = mm.toff[NE], nunits = ntiles * 4, sub = F.tid >> 8;
    for (int u0 = F.vcu * 2; u0 < nunits; u0 += F.G * 2) {
        const int u = u0 + sub; const bool ok = u < nunits;
        int e = 0, tl = 0; if (ok) moe_find(mm, u >> 2, e, tl);
        const int n0 = (u & 3) * 64, mvalid = ok ? min(64, mm.cnt[e] - tl * 64) : 0;
        RowBf16 ar{H2, list + (size_t)e * CAP + tl * 64, D};
        float* G = gbuf + (size_t)(mm.offs[e] + tl * 64) * 256;
        fma_tile64(F.lds + RING_OFF, ar, mvalid, w_gate + (size_t)e * D * 256, 256, n0, D, EpiActF{G, 1});
        fma_tile64(F.lds + RING_OFF, ar, mvalid, w_up + (size_t)e * D * 256, 256, n0, D, EpiActF{G, 0});
    }
}
__device__ __forceinline__ void moe_simple_down(Frame& F, const float* gbuf, const float* w_down, const int* cnt_g, const int* list, const float* wts, float* routed) {
    const MoeMap mm = moe_map_build(F, cnt_g, 64);
    const int ntiles = mm.toff[NE], nunits = ntiles * 16, sub = F.tid >> 8;
    for (int u0 = F.vcu * 2; u0 < nunits; u0 += F.G * 2) {
        const int u = u0 + sub; const bool ok = u < nunits;
        int e = 0, tl = 0; if (ok) moe_find(mm, u >> 4, e, tl);
        const int n0 = (u & 15) * 64, mvalid = ok ? min(64, mm.cnt[e] - tl * 64) : 0;
        RowF32 ar{gbuf + (size_t)(mm.offs[e] + tl * 64) * 256, 256};
        fma_tile64(F.lds + RING_OFF, ar, mvalid, w_down + (size_t)e * 256 * D, D, n0, 256, EpiScatterF{routed, list + (size_t)e * CAP + tl * 64, wts});
    }
}
__device__ __forceinline__ void swa_simple(Frame& F, int gw0, int ngw, const bf16* SQ, const bf16* SK, const bf16* SV, const float* sinks, bf16* OMIX) {
    for (int blk = gw0; blk < 2 * 8 * (SEQ / 64); blk += ngw) {
        const int tb = blk % (SEQ / 64), h = (blk / (SEQ / 64)) % 8, b = blk / (SEQ / 64 * 8);
        const int t0 = tb * 64, t = t0 + F.lane, kvh = h >> 2;
        float q[64], o[64];
        const bf16* qp = SQ + ((size_t)b * SEQ + t) * 512 + h * 64;
#pragma unroll
        for (int d = 0; d < 64; ++d) { q[d] = bf2f(qp[d]); o[d] = 0.f; }
        float m = sinks[h] * LOG2E, l = 1.f;
        const int jlo = max(0, t0 - 127);
        for (int j = jlo; j <= t0 + 63; ++j) {
            const bf16* kp = SK + ((size_t)b * SEQ + j) * 128 + kvh * 64;
            const bf16* vp = SV + ((size_t)b * SEQ + j) * 128 + kvh * 64;
            float s = 0.f;
#pragma unroll
            for (int d = 0; d < 64; ++d) s += q[d] * bf2f(kp[d]);
            const bool valid = (j <= t) && (j >= t - 127);
            if (!valid) s = -INFINITY;
            if (s > m) {
                const float sc = exp2f(m - s); l *= sc;
#pragma unroll
                for (int d = 0; d < 64; ++d) o[d] *= sc;
                m = s;
            }
            const float p = exp2f(s - m); l += p;
#pragma unroll
            for (int d = 0; d < 64; ++d) o[d] += p * bf2f(vp[d]);
        }
        const float il = 1.f / l;
        bf16* op = OMIX + ((size_t)b * SEQ + t) * 1024 + 512 + h * 64;
#pragma unroll
        for (int d = 0; d < 64; ++d) op[d] = (bf16)f2bf(o[d] * il);
    }
}
__device__ __forceinline__ void gla_rec_simple(Frame& F, int bh, const bf16* GQ, const bf16* GK, const bf16* GV, const float* LA, float* og) {
    const int b = bh >> 2, h = bh & 3, dv = F.tid & 127;
    LAS float* sq = (LAS float*)(F.lds + RING_OFF); LAS float* sk = sq + 2048; LAS float* sa = sk + 2048; LAS float* sv = sa + 2048;
    float St[64];
#pragma unroll
    for (int d = 0; d < 64; ++d) St[d] = 0.f;
    for (int t0 = 0; t0 < SEQ; t0 += 32) {
        for (int i = F.tid; i < 2048; i += NTHREADS) {
            const int tt = i >> 6, d = i & 63; const size_t row = (size_t)b * SEQ + t0 + tt;
            sq[i] = bf2f(GQ[row * 256 + h * 64 + d]); sk[i] = bf2f(GK[row * 256 + h * 64 + d]); sa[i] = expf(LA[row * 256 + h * 64 + d]);
        }
        for (int i = F.tid; i < 4096; i += NTHREADS) {
            const int tt = i >> 7, d = i & 127; const size_t row = (size_t)b * SEQ + t0 + tt;
            sv[i] = bf2f(GV[row * 512 + h * 128 + d]);
        }
        LDS_WAIT(); __syncthreads();
        if (F.tid < 128) {
            for (int tt = 0; tt < 32; ++tt) {
                const float v = sv[tt * 128 + dv];
                float o = 0.f;
#pragma unroll
                for (int d = 0; d < 64; ++d) { St[d] = sa[tt * 64 + d] * St[d] + sk[tt * 64 + d] * v; o += sq[tt * 64 + d] * St[d]; }
                og[((size_t)b * SEQ + t0 + tt) * 512 + h * 128 + dv] = o;
            }
        }
        LDS_WAIT(); __syncthreads();
    }
}
__device__ __forceinline__ void gla_out_simple(Frame& F, const float* og, const bf16* SGR, const float* g_out, bf16* OMIX) {
    const int gw = F.vcu * NWAVES + F.wave, NGW = F.G * NWAVES, lane = F.lane;
    for (int w = gw; w < M * 4; w += NGW) {
        const size_t row = (size_t)(w >> 2); const int h = w & 3;
        const float a = og[row * 512 + h * 128 + lane], b = og[row * 512 + h * 128 + 64 + lane];
        const float r = rsqrtf(wave_sum(a * a + b * b) * (1.f / 128.f) + EPS);
        const float ga = bf2f(SGR[row * 512 + h * 128 + lane]), gb = bf2f(SGR[row * 512 + h * 128 + 64 + lane]);
        OMIX[row * 1024 + h * 128 + lane] = (bf16)f2bf(a * r * g_out[lane] * ga);
        OMIX[row * 1024 + h * 128 + 64 + lane] = (bf16)f2bf(b * r * g_out[64 + lane] * gb);
    }
}
struct Args { const void* in[22]; float* out; unsigned char* ws; int ph_lo, ph_hi, li, pad; };
enum { PH_PREP = 0, PH_XN = 1, PH_INPROJ = 2, PH_MIX = 3, PH_MIX2 = 4, PH_OUTPROJ = 5, PH_NORM2 = 6, PH_FFN1 = 7, PH_ROUTE = 8, PH_MOE_GU = 9, PH_MOE_DOWN = 10, PH_FINAL = 11, PH_END = 12 };

__global__ void __launch_bounds__(NTHREADS, 2) mega_fwd(Args args) {
    extern __shared__ __attribute__((aligned(16))) unsigned char lds[];
    Frame F;
    F.lds = (LAS unsigned char*)lds;
    F.MISC = (volatile LAS unsigned*)(F.lds + MISC_OFF);
    F.tid = threadIdx.x; F.lane = F.tid & 63; F.wave = __builtin_amdgcn_readfirstlane(F.tid >> 6);
    F.G = gridDim.x; { const int bx = blockIdx.x; F.vcu = (F.G % 8 == 0) ? (bx % 8) * (F.G / 8) + bx / 8 : bx; }
    F.ws = args.ws; F.ctl = (gu32*)(args.ws + WS_CTL);
    for (int u = F.tid; u < (LDS_BYTES - LDSCTL_OFF) / 4; u += NTHREADS) ((LAS unsigned*)(F.lds + LDSCTL_OFF))[u] = 0u;
    __syncthreads();
    XcdBarrier bar = xcd_barrier_post((unsigned*)(F.ctl + CW_BAR) + args.li * XCD_BAR_WORDS, F.MISC + 8);
    const int lo = args.ph_lo, hi = args.ph_hi;
#define IN(k) (lo <= (k) && (k) < hi)
#define BOTH(k) (IN(k) && IN((k) + 1))
#define SEAM(k) do { if (BOTH(k)) xcd_barrier(bar); } while (0)
    const float* x = (const float*)args.in[0];
    unsigned char* ws = F.ws;
    int* cnt = (int*)(ws + WS_CTL) + CW_CNT; int* list = (int*)(ws + WS_LIST); float* wts = (float*)(ws + WS_WTS);
    float* routed = (float*)(ws + WS_NAIVE); float* gbuf = (float*)(ws + WS_SLOTS);

    if (IN(PH_PREP)) {
        P0In I{(const float*)args.in[1], (const float*)args.in[3], (const float*)args.in[4], (const float*)args.in[6], (const float*)args.in[7], (const float*)args.in[11],
               (const float*)args.in[13], (const float*)args.in[18], (const float*)args.in[19], (const float*)args.in[20], (const int*)args.in[2]};
        p0a_prep(F, I);
        SEAM(PH_PREP);
    }
    if (IN(PH_XN)) {
        norm_rows(F, x, (const float*)args.in[5], 0, 1024, (bf16*)(ws + WS_XN));
        SEAM(PH_XN);
    }
    if (IN(PH_INPROJ)) {
        pg8::Gemm g{(const pg8::bf16_t*)(ws + WS_XN), (const pg8::bf16_t*)(ws + WS_W1T), M, N1, D};
        pg8::StaticOrder S; S.init(M, N1, F.G, (int)blockIdx.x);
        EpiP1 E{ws, (const float*)args.in[8]};
        pg8::gemm_phase<EpiP1, pg8::StaticOrder, true, true>(F.lds + RING_OFF, g, S, E);
        SEAM(PH_INPROJ);
    }
    if (IN(PH_MIX)) {
        float* og = (float*)(ws + WS_NAIVE + 64 * MiB);
        if (F.vcu < 8) gla_rec_simple(F, F.vcu, (const bf16*)(ws + WS_GQ), (const bf16*)(ws + WS_GK), (const bf16*)(ws + WS_GV), (const float*)(ws + WS_LA), og);
        else swa_simple(F, (F.vcu - 8) * NWAVES + F.wave, (F.G - 8) * NWAVES, (const bf16*)(ws + WS_SQ), (const bf16*)(ws + WS_SK), (const bf16*)(ws + WS_SV), (const float*)args.in[10], (bf16*)(ws + WS_OMIX));
        SEAM(PH_MIX);
    }
    if (IN(PH_MIX2)) {
        gla_out_simple(F, (const float*)(ws + WS_NAIVE + 64 * MiB), (const bf16*)(ws + WS_SGR), (const float*)args.in[9], (bf16*)(ws + WS_OMIX));
        SEAM(PH_MIX2);
    }
    if (IN(PH_OUTPROJ)) {
        pg8::Gemm g{(const pg8::bf16_t*)(ws + WS_OMIX), (const pg8::bf16_t*)(ws + WS_WOT), M, D, D};
        pg8::StaticOrder S; S.init(M, D, F.G, (int)blockIdx.x);
        EpiXmid E{x, (const float*)(ws + WS_MOD), (float*)(ws + WS_XMID)};
        pg8::gemm_phase<EpiXmid, pg8::StaticOrder, true, true>(F.lds + RING_OFF, g, S, E);
        SEAM(PH_OUTPROJ);
    }
    if (IN(PH_NORM2)) {
        norm_rows(F, (const float*)(ws + WS_XMID), (const float*)args.in[12], 3072, 4096, (bf16*)(ws + WS_H2));
        SEAM(PH_NORM2);
    }
    if (IN(PH_FFN1)) {
        pg8::Gemm g{(const pg8::bf16_t*)(ws + WS_H2), (const pg8::bf16_t*)(ws + WS_W4T), M, 768, D};
        pg8::StaticOrder S; S.init(M, 768, F.G, (int)blockIdx.x);
        EpiP4 E{(float*)(ws + WS_LOGITS), (bf16*)(ws + WS_SACT)};
        pg8::gemm_phase<EpiP4, pg8::StaticOrder, true, true>(F.lds + RING_OFF, g, S, E);
        SEAM(PH_FFN1);
    }
    if (IN(PH_ROUTE)) {
        route_tokens(F, (const float*)(ws + WS_LOGITS), (const float*)args.in[14], cnt, list, wts);
        for (size_t i = (size_t)blockIdx.x * NTHREADS + F.tid; i < (size_t)M * D / 4; i += (size_t)F.G * NTHREADS) ((f32x4*)routed)[i] = (f32x4){0.f, 0.f, 0.f, 0.f};
        pg8::Gemm g{(const pg8::bf16_t*)(ws + WS_SACT), (const pg8::bf16_t*)(ws + WS_WSDT), M, D, 256};
        pg8::StaticOrder S; S.init(M, D, F.G, (int)blockIdx.x);
        EpiF32x E{(float*)(ws + WS_SHOUT), D};
        pg8::gemm_phase<EpiF32x, pg8::StaticOrder, true, true>(F.lds + RING_OFF, g, S, E);
        SEAM(PH_ROUTE);
    }
    if (IN(PH_MOE_GU)) {
        moe_simple_gu(F, (const bf16*)(ws + WS_H2), (const float*)args.in[15], (const float*)args.in[16], cnt, list, gbuf);
        SEAM(PH_MOE_GU);
    }
    if (IN(PH_MOE_DOWN)) {
        moe_simple_down(F, gbuf, (const float*)args.in[17], cnt, list, wts, routed);
        SEAM(PH_MOE_DOWN);
    }
    if (IN(PH_FINAL)) {
        final_rows(F, (const float*)(ws + WS_XMID), (const float*)(ws + WS_SHOUT), routed, (const float*)args.in[21], args.out);
    }
#undef IN
#undef BOTH
#undef SEAM
}
extern "C" void kernel_launch(void* const* d_in, const int* in_sizes, int n_in, void* d_out, int out_size, void* d_ws, size_t ws_size, hipStream_t stream) {
    static int grid = 0;
    if (grid == 0) {
        if (n_in != 22 || out_size != M * D || ws_size < (size_t)1000 * MiB) { fprintf(stderr, "kernel_launch: unexpected shapes (n_in %d, out %d, ws %zu)\n", n_in, out_size, ws_size); grid = -1; return; }
        int dev = 0, cus = 0, per_cu = 0;
        if (hipGetDevice(&dev) != hipSuccess || hipDeviceGetAttribute(&cus, hipDeviceAttributeMultiprocessorCount, dev) != hipSuccess) { grid = -1; return; }
        if (hipFuncSetAttribute((const void*)mega_fwd, hipFuncAttributeMaxDynamicSharedMemorySize, LDS_BYTES) != hipSuccess) { fprintf(stderr, "kernel_launch: hipFuncSetAttribute failed\n"); grid = -1; return; }
        if (hipOccupancyMaxActiveBlocksPerMultiprocessor(&per_cu, (const void*)mega_fwd, NTHREADS, LDS_BYTES) != hipSuccess || per_cu < 1) fprintf(stderr, "kernel_launch: occupancy query reports %d\n", per_cu);
        (void)hipGetLastError();
        grid = cus;
    }
    if (grid < 0) return;
    unsigned char* ws = (unsigned char*)d_ws;
    (void)hipMemsetAsync(ws + WS_CTL, 0, CTL_ZERO_BYTES, stream);
    Args a{};
    for (int i = 0; i < 22; ++i) a.in[i] = d_in[i];
    a.out = (float*)d_out; a.ws = ws;
    a.ph_lo = 0; a.ph_hi = PH_END; a.li = 0;
    hipLaunchKernelGGL(mega_fwd, dim3(grid), dim3(NTHREADS), LDS_BYTES, stream, a);
}
```

```cpp
#include <hip/hip_runtime.h>
#include <cstdio>
#include <cstdint>
#include <math.h>
namespace pg8 {
#define PG8_LAS __attribute__((address_space(3)))
typedef unsigned short bf16_t;
typedef short bf16x8 __attribute__((ext_vector_type(8)));
typedef float f32x4 __attribute__((ext_vector_type(4)));
typedef unsigned u32x4 __attribute__((ext_vector_type(4)));
constexpr int BM = 256, BK = 64, HALF = 128, HTB = HALF * BK * 2  , STAGE_BYTES = 8 * HTB, NXCD = 8, WGM = 8;

__host__ __device__ __forceinline__ int lds_byte(int r, int c) { const int st = (r >> 4) * 2 + (c >> 5), rr = r & 15, cc = c & 31, ob = rr * 64 + cc * 2; return st * 1024 + (ob ^ (((ob >> 9) & 1) << 5)); }
__host__ __device__ __forceinline__ void stage_rc(int b, int& R, int& C) { const int st = b / 1024, sb = b % 1024, swz = sb ^ (((sb >> 9) & 1) << 5); R = (st >> 1) * 16 + swz / 64; C = (st & 1) * 32 + (swz % 64) / 2; }
__host__ __device__ __forceinline__ int perm32(int rho) { const int n = rho >> 4, i = rho & 15; return 8 * (i >> 2) + 4 * n + (i & 3); }

struct Unit { int pm, pn; };
struct Gemm { const bf16_t* A; const bf16_t* Bt; int M, N, K; };

struct StaticOrder {
    int nM, nN, nwg, G, c;
    __host__ __device__ void init(int M, int N, int G_, int c_) { nM = M / BM; nN = N / BM; nwg = nM * nN; G = G_; c = c_; }
    __host__ __device__ bool next(int i, Unit& u) const {
        const long L = (long)i * G + c; if (L >= nwg) return false;
        int wgid = (int)L; { const int q = nwg / NXCD, r = nwg % NXCD, xcd = wgid % NXCD, off = wgid / NXCD; wgid = (xcd < r ? xcd * (q + 1) : r * (q + 1) + (xcd - r) * q) + off; }
        const int nig = WGM * nN, gid = wgid / nig, fm = gid * WGM, gsz = (nM - fm) < WGM ? (nM - fm) : WGM;
        u.pm = fm + ((wgid % nig) % gsz); u.pn = (wgid % nig) / gsz; return true;
    }
    __device__ __forceinline__ void a_ready(const Unit&) const {}
    __device__ __forceinline__ void done(const Unit&) const {}
};

__device__ __forceinline__ unsigned cvt_pk_bf16(float lo, float hi) { unsigned r; asm volatile("v_cvt_pk_bf16_f32 %0, %1, %2" : "=v"(r) : "v"(lo), "v"(hi)); return r; }
typedef float f32x2 __attribute__((ext_vector_type(2)));
__device__ __forceinline__ f32x2 gelu_pk(f32x2 v) {
    const f32x2 av = __builtin_elementwise_abs(v), d = av * 0.2316418882f + 1.0f;
    f32x2 t; t.x = __builtin_amdgcn_rcpf(d.x); t.y = __builtin_amdgcn_rcpf(d.y);
    f32x2 q = t * 0.5307027145f + (-0.7265760135f); q = q * t + 0.7107068705f; q = q * t + (-0.142248368f); q = q * t + 0.127414796f; q = q * t;
    const f32x2 s = (v * v) * (-0.72134752044f);
    f32x2 e; e.x = __builtin_amdgcn_exp2f(s.x); e.y = __builtin_amdgcn_exp2f(s.y);
    const f32x2 m = v * (q * e), r = v - m;
    f32x2 o; o.x = v.x < 0.f ? m.x : r.x; o.y = v.y < 0.f ? m.y : r.y; return o;
}

template <int ACT  > struct EpiBf16 {
    static constexpr bool PERM = true, AFTER_DRAIN = false; static_assert(ACT == 0 || ACT == 1, "EpiBf16: ACT is 0 (none) or 1 (gelu_pk)");
    bf16_t* O; int ldc; const float* bias; int split_cols; size_t split_stride; float scale0;
    __device__ __forceinline__ void operator()(const f32x4 (&acc)[2][2][4][2], const Unit& u, int wr, int wc, int fr, int fq) const {
        const int row0 = u.pm * BM + wr * 64 + fr; int colt = u.pn * BM; bf16_t* base = O;
        float sc = 1.f; if (split_cols) { const int t = colt / split_cols; base += (size_t)t * split_stride; colt -= t * split_cols; if (t == 0) sc = scale0; }
        const int col0 = colt + wc * 32 + 8 * fq, bcol0 = u.pn * BM + wc * 32 + 8 * fq;
        f32x4 bv[2][2];
#pragma unroll
        for (int bj = 0; bj < 2; ++bj)
#pragma unroll
            for (int n = 0; n < 2; ++n) bv[bj][n] = bias ? *(const f32x4*)(bias + bcol0 + bj * HALF + 4 * n) : (f32x4){0.f, 0.f, 0.f, 0.f};
#pragma unroll
        for (int ai = 0; ai < 2; ++ai)
#pragma unroll
            for (int m = 0; m < 4; ++m) { bf16_t* rowp = base + (size_t)(row0 + ai * HALF + m * 16) * ldc + col0;
#pragma unroll
                for (int bj = 0; bj < 2; ++bj) { f32x4 v0 = acc[ai][bj][m][0] + bv[bj][0], v1 = acc[ai][bj][m][1] + bv[bj][1];
                    if (ACT == 1) { f32x2 a = gelu_pk((f32x2){v0[0], v0[1]}), b = gelu_pk((f32x2){v0[2], v0[3]}), c = gelu_pk((f32x2){v1[0], v1[1]}), d = gelu_pk((f32x2){v1[2], v1[3]});
                        v0 = (f32x4){a.x, a.y, b.x, b.y}; v1 = (f32x4){c.x, c.y, d.x, d.y}; }
                    v0 = v0 * sc; v1 = v1 * sc; u32x4 w; w.x = cvt_pk_bf16(v0[0], v0[1]); w.y = cvt_pk_bf16(v0[2], v0[3]); w.z = cvt_pk_bf16(v1[0], v1[1]); w.w = cvt_pk_bf16(v1[2], v1[3]);
                    *(u32x4*)(rowp + bj * HALF) = w; } }
    }
};

struct PanelStats {
    unsigned* xbuf;
    unsigned* cnt;
    unsigned* tmo;
    int ntn; float eps;
    unsigned code;
    __device__ __forceinline__ bool run(const f32x4 (&v)[2][2][4][2], const Unit& u, int wr, int wc, int fr, int fq, PG8_LAS unsigned char* lds, int wid, int lane) const {
        typedef float f32x2v __attribute__((ext_vector_type(2)));
        PG8_LAS f32x2v* P = (PG8_LAS f32x2v*)lds;
        PG8_LAS f32x2v* S = (PG8_LAS f32x2v*)(lds + 8192);
        PG8_LAS unsigned* flag = (PG8_LAS unsigned*)(lds + 8192 + 2048);
#pragma unroll
        for (int ai = 0; ai < 2; ++ai)
#pragma unroll
            for (int m = 0; m < 4; ++m) {
                float s = 0.f;
#pragma unroll
                for (int bj = 0; bj < 2; ++bj)
#pragma unroll
                    for (int n = 0; n < 2; ++n) { const f32x4 x = v[ai][bj][m][n]; s += (x[0] + x[1]) + (x[2] + x[3]); }
                s += __shfl_xor(s, 16); s += __shfl_xor(s, 32);
                const float mw = s * (1.0f / 64.0f); float q = 0.f;
#pragma unroll
                for (int bj = 0; bj < 2; ++bj)
#pragma unroll
                    for (int n = 0; n < 2; ++n) { const f32x4 d = v[ai][bj][m][n] - mw; q += (d[0] * d[0] + d[1] * d[1]) + (d[2] * d[2] + d[3] * d[3]); }
                q += __shfl_xor(q, 16); q += __shfl_xor(q, 32);
                if (fq == 0) P[(ai * HALF + wr * 64 + m * 16 + fr) * 4 + wc] = (f32x2v){mw, q};
            }
        asm volatile("s_waitcnt lgkmcnt(0)" ::: "memory"); __builtin_amdgcn_s_barrier(); asm volatile("" ::: "memory");
#if defined(BROKEN_EXCHANGE_NO_WAIT)
#warning BROKEN CONTROL BUILD: the row-statistics exchange does not wait; results are wrong by design
        if (blockIdx.x >= 64) { const long long t0_ = clock64(); while (clock64() - t0_ < 60000) __builtin_amdgcn_s_sleep(8); }
#endif
        const int row = wid * 32 + (lane & 31);
        if (lane < 32) {
            const f32x2v a = P[row * 4 + 0], b = P[row * 4 + 1], c = P[row * 4 + 2], d = P[row * 4 + 3];
            const float mt = (a.x + b.x + c.x + d.x) * 0.25f;
            const float da = a.x - mt, db = b.x - mt, dc = c.x - mt, dd = d.x - mt;
            const float m2 = (a.y + b.y) + (c.y + d.y) + 64.0f * ((da * da + db * db) + (dc * dc + dd * dd));
            unsigned long long* slot = (unsigned long long*)xbuf + ((size_t)(u.pm * BM + row) * 4 + u.pn);
            __hip_atomic_store(slot, ((unsigned long long)__float_as_uint(m2) << 32) | __float_as_uint(mt), __ATOMIC_RELAXED, __HIP_MEMORY_SCOPE_AGENT);
        }
        asm volatile("s_waitcnt vmcnt(0)" ::: "memory");
        if (lane == 0) __hip_atomic_fetch_add(cnt + 64 * u.pm, 1u, __ATOMIC_RELAXED, __HIP_MEMORY_SCOPE_AGENT);
        if (wid == 0) {
            bool dead = false; const unsigned long long t0 = __builtin_amdgcn_s_memrealtime(); const unsigned want = 8u * (unsigned)ntn;
            for (;;) {
#if defined(BROKEN_EXCHANGE_NO_WAIT)
                break;
#endif
                if ((unsigned)__builtin_amdgcn_readfirstlane(__hip_atomic_load(cnt + 64 * u.pm, __ATOMIC_RELAXED, __HIP_MEMORY_SCOPE_AGENT)) >= want) break;
                if (__builtin_amdgcn_s_memrealtime() - t0 > 2000000ull) {
                    if (lane == 0) { unsigned expect = 0u; __hip_atomic_compare_exchange_strong(tmo + 1, &expect, code | (unsigned)(u.pm & 0xff), __ATOMIC_RELAXED, __ATOMIC_RELAXED, __HIP_MEMORY_SCOPE_AGENT);
                                     __hip_atomic_store(tmo, 1u, __ATOMIC_RELAXED, __HIP_MEMORY_SCOPE_AGENT); }
                    dead = true; break; }
                __builtin_amdgcn_s_sleep(2);
            }
            __builtin_amdgcn_fence(__ATOMIC_ACQUIRE, "agent");
            if (lane == 0) flag[0] = dead ? 1u : 0u;
        }
        asm volatile("s_waitcnt vmcnt(0) lgkmcnt(0)" ::: "memory"); __builtin_amdgcn_s_barrier(); asm volatile("" ::: "memory");
        const bool bad = flag[0] != 0u;
        if (lane < 32) {
            const unsigned long long* slot = (const unsigned long long*)xbuf + (size_t)(u.pm * BM + row) * 4; float mt[4], m2[4]; float ms = 0.f;
#pragma unroll
            for (int t = 0; t < 4; ++t) { if (t < ntn) { const unsigned long long w = __hip_atomic_load(slot + t, __ATOMIC_RELAXED, __HIP_MEMORY_SCOPE_AGENT); mt[t] = __uint_as_float((unsigned)w); m2[t] = __uint_as_float((unsigned)(w >> 32)); } else { mt[t] = 0.f; m2[t] = 0.f; } ms += mt[t]; }
            const float mean = ms / (float)ntn; float q = 0.f;
#pragma unroll
            for (int t = 0; t < 4; ++t) if (t < ntn) { const float dm = mt[t] - mean; q += m2[t] + 256.0f * dm * dm; }
            S[row] = (f32x2v){mean, 1.0f / sqrtf(q / (256.0f * (float)ntn) + eps)};
        }
        asm volatile("s_waitcnt lgkmcnt(0)" ::: "memory"); __builtin_amdgcn_s_barrier(); asm volatile("" ::: "memory");
        return bad;
    }
};

template <class Epi, class Sched, bool ALIGN_EPI = false, bool SP2 = false>
__device__ __forceinline__ void gemm_phase(PG8_LAS unsigned char* lds, const Gemm g, const Sched& S, const Epi& E) {
    const int tid = threadIdx.x, wid = __builtin_amdgcn_readfirstlane(tid >> 6), lane = tid & 63, wr = wid >> 2, wc = wid & 3, fr = lane & 15, fq = lane >> 4;
    const int K = g.K, nt = K / BK;
    unsigned voffA[2], voffB[2];
#pragma unroll
    for (int i = 0; i < 2; ++i) { int R, C; stage_rc(tid * 16 + i * 8192, R, C); const int Rb = Epi::PERM ? ((R & ~31) + perm32(R & 31)) : R;
        voffA[i] = (unsigned)(R * K + C) * 2u; voffB[i] = (unsigned)(Rb * K + C) * 2u; }
    const size_t kstep = (size_t)(BK * 2);
    const size_t hstep = (size_t)HALF * K * 2;
    const size_t tstep = 2 * hstep;
    const unsigned ldsw = (unsigned)wid * 1024u;
    const int aoff = lds_byte(wr * 64 + fr, fq * 8), boff = lds_byte(wc * 32 + fr, fq * 8);
#define PG8_SA(b, h) (((b) * 2 + (h)) * HTB)
#define PG8_SB(b, h) ((4 + (b) * 2 + (h)) * HTB)
#define PG8_STAGE(bufoff, gbase, voff) do { _Pragma("unroll") for (int _i = 0; _i < 2; ++_i) \
        __builtin_amdgcn_global_load_lds((const unsigned*)((const char*)(gbase) + (voff)[_i]), (PG8_LAS unsigned*)(lds + (bufoff) + ldsw + _i * 8192), 16, 0, 0); } while (0)
#define PG8_LDA(dst, b, h) do { _Pragma("unroll") for (int m = 0; m < 4; ++m) _Pragma("unroll") for (int k = 0; k < 2; ++k) dst[m][k] = *(const PG8_LAS bf16x8*)(lds + PG8_SA(b, h) + aoff + m * 2048 + k * 1024); } while (0)
#define PG8_LDB(dst, b, h) do { _Pragma("unroll") for (int n = 0; n < 2; ++n) _Pragma("unroll") for (int k = 0; k < 2; ++k) dst[n][k] = *(const PG8_LAS bf16x8*)(lds + PG8_SB(b, h) + boff + n * 2048 + k * 1024); } while (0)
#define PG8_MMA(ai, bj, At, Bt) do { __builtin_amdgcn_s_setprio(1); _Pragma("unroll") for (int m = 0; m < 4; ++m) _Pragma("unroll") for (int n = 0; n < 2; ++n) _Pragma("unroll") for (int k = 0; k < 2; ++k) \
        acc[ai][bj][m][n] = __builtin_amdgcn_mfma_f32_16x16x32_bf16(Bt[n][k], At[m][k], acc[ai][bj][m][n], 0, 0, 0); __builtin_amdgcn_s_setprio(0); } while (0)
#define PG8_WAIT_V(n) asm volatile("s_waitcnt vmcnt(" #n ")" ::: "memory")
#define PG8_WAIT_L(n) asm volatile("s_waitcnt lgkmcnt(" #n ")" ::: "memory")
#define PG8_BAR __builtin_amdgcn_s_barrier()
#define PG8_SCHED __builtin_amdgcn_sched_barrier(0)
    Unit cur, nxt; int ui = 0;
    if (!S.next(0, cur)) return;
    f32x4 acc[2][2][4][2];
#pragma unroll
    for (int a = 0; a < 2; ++a)
#pragma unroll
        for (int b = 0; b < 2; ++b)
#pragma unroll
            for (int m = 0; m < 4; ++m)
#pragma unroll
                for (int n = 0; n < 2; ++n) acc[a][b][m][n] = (f32x4){0.f, 0.f, 0.f, 0.f};
    bf16x8 At[4][2], B0[2][2], B1[2][2];
    const char* cA = (const char*)g.A + (size_t)cur.pm * tstep; const char* cB = (const char*)g.Bt + (size_t)cur.pn * tstep;
    S.a_ready(cur);
    if constexpr (SP2) {
        PG8_STAGE(PG8_SB(0, 0), cB, voffB); PG8_STAGE(PG8_SB(0, 1), cB + hstep, voffB); PG8_STAGE(PG8_SA(0, 0), cA, voffA); PG8_STAGE(PG8_SA(0, 1), cA + hstep, voffA);
        if (wr == 1) PG8_BAR;
        PG8_WAIT_V(2); PG8_BAR;
        PG8_STAGE(PG8_SB(1, 0), cB + kstep, voffB); PG8_STAGE(PG8_SA(1, 0), cA + kstep, voffA); PG8_STAGE(PG8_SB(1, 1), cB + hstep + kstep, voffB);
        PG8_WAIT_V(6); PG8_BAR;
    } else {
        PG8_STAGE(PG8_SB(0, 0), cB, voffB); PG8_STAGE(PG8_SA(0, 0), cA, voffA); PG8_STAGE(PG8_SB(0, 1), cB + hstep, voffB); PG8_STAGE(PG8_SA(0, 1), cA + hstep, voffA);
        if (wr == 1) PG8_BAR;
        PG8_WAIT_V(4); PG8_BAR;
        PG8_STAGE(PG8_SB(1, 0), cB + kstep, voffB); PG8_STAGE(PG8_SA(1, 0), cA + kstep, voffA); PG8_STAGE(PG8_SB(1, 1), cB + hstep + kstep, voffB);
        PG8_WAIT_V(6); PG8_BAR;
    }
    for (;;) {
        const bool has_next = S.next(ui + 1, nxt);
        const char* nA = has_next ? (const char*)g.A + (size_t)nxt.pm * tstep : cA; const char* nB = has_next ? (const char*)g.Bt + (size_t)nxt.pn * tstep : cB;
        for (int t = 0; t < nt; t += 2) {
            const bool last = (t == nt - 2);
            const char* a1 = cA + (size_t)(t + 1) * kstep;
            const char* a2 = last ? nA : cA + (size_t)(t + 2) * kstep; const char* b2 = last ? nB : cB + (size_t)(t + 2) * kstep;
            const char* a3 = a2 + kstep; const char* b3 = b2 + kstep;
            if (last && has_next) S.a_ready(nxt);
            if constexpr (SP2) {
            PG8_LDB(B0, 0, 0); PG8_LDB(B1, 0, 1); PG8_SCHED; PG8_LDA(At, 0, 0); PG8_STAGE(PG8_SA(1, 1), a1 + hstep, voffA);
            PG8_WAIT_V(8); PG8_WAIT_L(0); PG8_BAR; PG8_MMA(0, 0, At, B0); PG8_MMA(0, 1, At, B1); PG8_BAR; PG8_SCHED;
            PG8_LDA(At, 0, 1); PG8_STAGE(PG8_SB(0, 0), b2, voffB); PG8_STAGE(PG8_SB(0, 1), b2 + hstep, voffB); PG8_STAGE(PG8_SA(0, 0), a2, voffA);
            PG8_WAIT_V(8); PG8_WAIT_L(0); PG8_BAR; PG8_MMA(1, 0, At, B0); PG8_MMA(1, 1, At, B1); PG8_BAR; PG8_SCHED;
            PG8_LDB(B0, 1, 0); PG8_LDB(B1, 1, 1); PG8_SCHED; PG8_LDA(At, 1, 0); PG8_STAGE(PG8_SA(0, 1), a2 + hstep, voffA);
            PG8_WAIT_V(8); PG8_WAIT_L(0); PG8_BAR; PG8_MMA(0, 0, At, B0); PG8_MMA(0, 1, At, B1); PG8_BAR; PG8_SCHED;
            PG8_LDA(At, 1, 1); PG8_STAGE(PG8_SB(1, 0), b3, voffB); PG8_STAGE(PG8_SB(1, 1), b3 + hstep, voffB); PG8_STAGE(PG8_SA(1, 0), a3, voffA);
            PG8_WAIT_V(8); PG8_WAIT_L(0); PG8_BAR; PG8_MMA(1, 0, At, B0); PG8_MMA(1, 1, At, B1); PG8_BAR; PG8_SCHED;
            } else {
            PG8_LDB(B0, 0, 0); PG8_SCHED; PG8_LDA(At, 0, 0); PG8_STAGE(PG8_SA(1, 1), a1 + hstep, voffA);
            PG8_WAIT_L(8); PG8_BAR; PG8_WAIT_L(0); PG8_MMA(0, 0, At, B0); PG8_BAR; PG8_SCHED;
            PG8_LDB(B1, 0, 1); PG8_STAGE(PG8_SB(0, 0), b2, voffB);
            PG8_BAR; PG8_WAIT_L(0); PG8_MMA(0, 1, At, B1); PG8_BAR;
            PG8_LDA(At, 0, 1); PG8_STAGE(PG8_SA(0, 0), a2, voffA);
            PG8_BAR; PG8_WAIT_L(0); PG8_MMA(1, 0, At, B0); PG8_BAR; PG8_SCHED;
            PG8_STAGE(PG8_SB(0, 1), b2 + hstep, voffB);
            PG8_WAIT_V(6); PG8_BAR; PG8_MMA(1, 1, At, B1); PG8_BAR;
            PG8_LDB(B0, 1, 0); PG8_SCHED; PG8_LDA(At, 1, 0); PG8_STAGE(PG8_SA(0, 1), a2 + hstep, voffA);
            PG8_WAIT_L(8); PG8_BAR; PG8_WAIT_L(0); PG8_MMA(0, 0, At, B0); PG8_BAR; PG8_SCHED;
            PG8_LDB(B1, 1, 1); PG8_STAGE(PG8_SB(1, 0), b3, voffB);
            PG8_BAR; PG8_WAIT_L(0); PG8_MMA(0, 1, At, B1); PG8_BAR;
            PG8_LDA(At, 1, 1); PG8_STAGE(PG8_SA(1, 0), a3, voffA);
            PG8_BAR; PG8_WAIT_L(0); PG8_MMA(1, 0, At, B0); PG8_BAR; PG8_SCHED;
            PG8_STAGE(PG8_SB(1, 1), b3 + hstep, voffB);
            PG8_WAIT_V(6); PG8_BAR; PG8_MMA(1, 1, At, B1); PG8_BAR;
            }
        }
        if constexpr (ALIGN_EPI) { if (wr == 0) PG8_BAR; }
        if constexpr (!Epi::AFTER_DRAIN) { E(acc, cur, wr, wc, fr, fq); S.done(cur); }
        if (!has_next) break;
#pragma unroll
        for (int a = 0; a < 2; ++a)
#pragma unroll
            for (int b = 0; b < 2; ++b)
#pragma unroll
                for (int m = 0; m < 4; ++m)
#pragma unroll
                    for (int n = 0; n < 2; ++n) acc[a][b][m][n] = (f32x4){0.f, 0.f, 0.f, 0.f};
        cur = nxt; cA = nA; cB = nB; ++ui;
        if constexpr (ALIGN_EPI) { if (wr == 1) PG8_BAR; }
    }
    PG8_WAIT_V(0);
    if constexpr (!ALIGN_EPI) { if (wr == 0) PG8_BAR; }
    PG8_BAR;
    if constexpr (Epi::AFTER_DRAIN) { E.fused(acc, cur, wr, wc, fr, fq, lds, wid, lane); S.done(cur); }
#undef PG8_SA
#undef PG8_SB
#undef PG8_STAGE
#undef PG8_LDA
#undef PG8_LDB
#undef PG8_MMA
#undef PG8_WAIT_V
#undef PG8_WAIT_L
#undef PG8_BAR
#undef PG8_SCHED
}
}
#define GAS __attribute__((address_space(1)))
#define LAS __attribute__((address_space(3)))
typedef unsigned short bf16;
typedef unsigned v4u __attribute__((ext_vector_type(4)));
typedef float f32x4 __attribute__((ext_vector_type(4)));
typedef short bf16x8 __attribute__((ext_vector_type(8)));
typedef GAS unsigned gu32;
typedef GAS unsigned long long gu64;
#define RLX_AGENT __ATOMIC_RELAXED, __HIP_MEMORY_SCOPE_AGENT
#define LDS_WAIT() asm volatile("s_waitcnt lgkmcnt(0)" ::: "memory")
#define VM_WAIT() asm volatile("s_waitcnt vmcnt(0)" ::: "memory")
__device__ __forceinline__ unsigned long long rt() { return __builtin_amdgcn_s_memrealtime(); }
__device__ __forceinline__ unsigned f2bf(float f) { unsigned u = __builtin_bit_cast(unsigned, f); return (u + 0x7fffu + ((u >> 16) & 1u)) >> 16; }
__device__ __forceinline__ unsigned pk2(float lo, float hi) { return f2bf(lo) | (f2bf(hi) << 16); }

#define XB_TMO      128
#define XB_XCNT(j)  (256  + 64 * (j))
#define XB_XSUB(j)  (1280 + 64 * (j))
#define XB_XGEN(j)  (2304 + 64 * (j))
#define XB_TOP      3328
#define XB_TOPGEN   3392
#define XCD_BAR_WORDS 3456
#define XB_SPIN_CAP (1u << 18)

__device__ __forceinline__ unsigned xb_ld(unsigned* p)              { return __hip_atomic_load(p, __ATOMIC_RELAXED, __HIP_MEMORY_SCOPE_AGENT); }
__device__ __forceinline__ unsigned xb_add(unsigned* p, unsigned v) { return __hip_atomic_fetch_add(p, v, __ATOMIC_RELAXED, __HIP_MEMORY_SCOPE_AGENT); }
__device__ __forceinline__ unsigned xb_xcc_id() { return (unsigned)__builtin_amdgcn_s_getreg((3 << 11) | 20) & 0xFu; }
#define XB_SPIN(cond, bar) do { unsigned _sp = 0; while (cond) { __builtin_amdgcn_s_sleep(1); \
    if ((++_sp & 255u) == 0u) { if (xb_ld(&(bar)[XB_TMO])) break; if (_sp > XB_SPIN_CAP) { atomicAdd(&(bar)[XB_TMO], 1u); break; } } } } while (0)

struct XcdBarrier {
    unsigned* bar; unsigned x;
    volatile LAS unsigned* st;
};

__device__ __forceinline__ XcdBarrier xcd_barrier_post(unsigned* bar, volatile LAS unsigned* st) {
    XcdBarrier b; b.bar = bar; b.x = xb_xcc_id(); b.st = st;
    if (threadIdx.x == 0) (void)xb_add(&bar[XB_XCNT(b.x)], 1u);
    return b;
}
__device__ __forceinline__ void xcd_barrier_complete(unsigned* bar, unsigned x, unsigned& nloc, unsigned& nx) {
    const unsigned G = gridDim.x * gridDim.y * gridDim.z;
    unsigned sum, cnt, mine, sp = 0u;
    for (;;) {
        sum = 0u; cnt = 0u; mine = 0u;
#pragma unroll
        for (unsigned j = 0; j < 16; ++j) { const unsigned c = xb_ld(&bar[XB_XCNT(j)]); sum += c; cnt += (c > 0u) ? 1u : 0u; mine = (j == x) ? c : mine; }
        if (sum == G) break;
        __builtin_amdgcn_s_sleep(1);
        if ((++sp & 255u) == 0u) { if (xb_ld(&bar[XB_TMO])) break; if (sp > XB_SPIN_CAP) { atomicAdd(&bar[XB_TMO], 1u); break; } }
    }
    nloc = mine > 0u ? mine : 1u; nx = cnt > 0u ? cnt : 1u;
}

__device__ __forceinline__ void xcd_barrier(const XcdBarrier& b) {
    asm volatile("s_waitcnt vmcnt(0)" ::: "memory");
    __syncthreads();
    if (threadIdx.x == 0) {
        unsigned* bar = b.bar;
        __builtin_amdgcn_s_waitcnt(0);
        unsigned nloc = b.st[0], nx = b.st[1];
        if (nloc == 0u) { xcd_barrier_complete(bar, b.x, nloc, nx); b.st[0] = nloc; b.st[1] = nx; }
        const unsigned old = xb_add(&bar[XB_XSUB(b.x)], 1u);
        const unsigned gen = old / nloc;
        if (old + 1u == (gen + 1u) * nloc) {
            __builtin_amdgcn_fence(__ATOMIC_RELEASE, "agent");
            asm volatile("s_waitcnt vmcnt(0)" ::: "memory");
            const unsigned og = xb_add(&bar[XB_TOP], 1u);
            const unsigned tg = og / nx;
            if (og + 1u == (tg + 1u) * nx) xb_add(&bar[XB_TOPGEN], 1u);
            else XB_SPIN(xb_ld(&bar[XB_TOPGEN]) == tg, bar);
            __builtin_amdgcn_fence(__ATOMIC_ACQUIRE, "agent");
            xb_add(&bar[XB_XGEN(b.x)], 1u);
            asm volatile("s_waitcnt vmcnt(0)" ::: "memory");
        } else {
            XB_SPIN(xb_ld(&bar[XB_XGEN(b.x)]) == gen, bar);
            __builtin_amdgcn_fence(__ATOMIC_ACQUIRE, "agent");
            asm volatile("s_waitcnt vmcnt(0)" ::: "memory");
        }
    }
    __syncthreads();
}
constexpr int NWAVES = 8, NTHREADS = 512;
constexpr int M = 16384, D = 1024, SEQ = 8192, INW = 2320, N1 = 2560, NE = 256, CAP = 16384;
constexpr float EPS = 1e-6f, LOG2E = 1.4426950408889634f, QS = 0.125f * 1.4426950408889634f;
constexpr size_t MiB = 1u << 20;
constexpr size_t WS_CTL = 0, CTL_ZERO_BYTES = 1 * MiB;
constexpr size_t WS_MOD = 1 * MiB, WS_CS = 2 * MiB, WS_W1T = 4 * MiB, WS_WOT = 10 * MiB, WS_W4T = 12 * MiB, WS_WSDT = 14 * MiB;
constexpr size_t WS_XN = 16 * MiB, WS_GQ = 48 * MiB, WS_GK = 56 * MiB, WS_GV = 64 * MiB, WS_LA = 80 * MiB, WS_SGR = 96 * MiB, WS_SQ = 112 * MiB, WS_SK = 128 * MiB, WS_SV = 132 * MiB;
constexpr size_t WS_OMIX = 136 * MiB, WS_XMID = 168 * MiB, WS_H2 = 232 * MiB, WS_LOGITS = 264 * MiB, WS_SACT = 280 * MiB, WS_SHOUT = 288 * MiB;
constexpr size_t WS_LIST = 352 * MiB, WS_WTS = 368 * MiB, WS_ACT = 370 * MiB, WS_GST = 440 * MiB, WS_SLOTS = 480 * MiB, WS_XCH = 740 * MiB, WS_NAIVE = 744 * MiB;
constexpr int CW_TMO = 0, CW_CODE = 1, CW_BAR = 4096, CW_SEAM = 16384, SEAM_BANK = 128 * 64, CW_CNT = 49152, CW_OFFS = 49152 + 512, CW_TOFF = 49152 + 1024;
constexpr int RING_OFF = 0, RING_BYTES = 131072, LDSCTL_OFF = RING_BYTES, MISC_OFF = LDSCTL_OFF + 320, LDS_BYTES = 147456;

__device__ __forceinline__ float bf2f(unsigned short h) { return __uint_as_float((unsigned)h << 16); }
__device__ __forceinline__ float siluf(float v) { return v / (1.f + __expf(-v)); }
__device__ __forceinline__ float wave_sum(float v) {
#pragma unroll
    for (int o = 1; o < 64; o <<= 1) v += __shfl_xor(v, o);
    return v;
}

struct Frame {
    LAS unsigned char* lds;
    volatile LAS unsigned* MISC;
    gu32* ctl;
    int tid, lane, wave, vcu, G;
    unsigned char* ws;
};

__device__ __forceinline__ void tr_writeout(bf16* WT, int K, int dst_row, int k0, LAS float* scr, int lane) {
    LDS_WAIT(); asm volatile("" ::: "memory");
    const int c = lane & 7;
#pragma unroll
    for (int j = 0; j < 4; ++j) { const int n = (lane >> 3) + 8 * j; const LAS float* s = scr + (8 * c) * 33 + n;
        v4u o; o.x = pk2(s[0 * 33], s[1 * 33]); o.y = pk2(s[2 * 33], s[3 * 33]); o.z = pk2(s[4 * 33], s[5 * 33]); o.w = pk2(s[6 * 33], s[7 * 33]);
        *(GAS v4u*)(WT + (size_t)(dst_row + n) * K + k0 + 8 * c) = o; }
    LDS_WAIT(); asm volatile("" ::: "memory");
}
__device__ __forceinline__ void tr_item(const float* W, int ldw, int col0, bf16* WT, int K, int dst_row0, int kb, int nb, LAS float* scr, int lane) {
    const int k0 = 64 * kb, n0 = 32 * nb;
#pragma unroll 8
    for (int i = 0; i < 32; ++i) { const int kk = 2 * i + (lane >> 5); scr[kk * 33 + (lane & 31)] = W[(size_t)(k0 + kk) * ldw + col0 + n0 + (lane & 31)]; }
    tr_writeout(WT, K, dst_row0 + n0, k0, scr, lane);
}
__device__ __forceinline__ void fold_item(const float* w_in, const float* w_up, bf16* WT, int kb, int nb, LAS float* scr, int lane) {
    const int k0 = 64 * kb, n0 = 32 * nb, n = n0 + (lane & 31);
    float wu[16];
#pragma unroll
    for (int r = 0; r < 16; ++r) wu[r] = w_up[r * 256 + n];
    for (int i = 0; i < 32; ++i) { const int kk = 2 * i + (lane >> 5); const float* wi = w_in + (size_t)(k0 + kk) * INW + 1024; float a = 0.f;
#pragma unroll
        for (int r = 0; r < 16; ++r) a += wi[r] * wu[r];
        scr[kk * 33 + (lane & 31)] = a; }
    tr_writeout(WT, 1024, 1024 + n0, k0, scr, lane);
}

struct P0In { const float *c, *w_ada, *b_ada, *w_in, *w_gk_up, *w_out, *w_router, *ws_gate, *ws_up, *ws_down; const int* positions; };
__device__ __forceinline__ void p0a_prep(Frame& F, const P0In& I) {
    bf16* W1t = (bf16*)(F.ws + WS_W1T); bf16* Wot = (bf16*)(F.ws + WS_WOT); bf16* W4t = (bf16*)(F.ws + WS_W4T); bf16* Wsdt = (bf16*)(F.ws + WS_WSDT);
    float* mod = (float*)(F.ws + WS_MOD); float* CS = (float*)(F.ws + WS_CS);
    if (F.vcu < 96) {
        const int n0 = 64 * F.vcu; float a0 = 0.f, a1 = 0.f;
        const float* wp = I.w_ada + (size_t)(128 * F.wave) * 6144 + n0 + F.lane;
#pragma unroll 8
        for (int k = 0; k < 128; ++k) { const float wv = wp[(size_t)k * 6144]; const int kk = 128 * F.wave + k;
            a0 += siluf(I.c[kk]) * wv; a1 += siluf(I.c[1024 + kk]) * wv; }
        LAS float* red = (LAS float*)(F.lds + RING_OFF + F.wave * 16384 + 12288);
        red[F.lane] = a0; red[64 + F.lane] = a1;
        LDS_WAIT(); __syncthreads();
        if (F.wave == 0) { float s0 = 0.f, s1 = 0.f;
#pragma unroll
            for (int w = 0; w < 8; ++w) { const LAS float* r = (const LAS float*)(F.lds + RING_OFF + w * 16384 + 12288); s0 += r[F.lane]; s1 += r[64 + F.lane]; }
            mod[n0 + F.lane] = s0 + I.b_ada[n0 + F.lane]; mod[6144 + n0 + F.lane] = s1 + I.b_ada[n0 + F.lane]; }
    }
    LAS float* scr = (LAS float*)(F.lds + RING_OFF + F.wave * 16384);
    const int gw = F.vcu * NWAVES + F.wave, NGW = F.G * NWAVES;
    for (int it = gw; it < 2304; it += NGW) {
        int r = it;
        if (r < 512) { tr_item(I.w_in, INW, 0, W1t, 1024, 0, r / 32, r % 32, scr, F.lane); continue; } r -= 512;
        if (r < 640) { tr_item(I.w_in, INW, 1040, W1t, 1024, 1280, r / 40, r % 40, scr, F.lane); continue; } r -= 640;
        if (r < 128) { fold_item(I.w_in, I.w_gk_up, W1t, r / 8, r % 8, scr, F.lane); continue; } r -= 128;
        if (r < 512) { tr_item(I.w_out, 1024, 0, Wot, 1024, 0, r / 32, r % 32, scr, F.lane); continue; } r -= 512;
        if (r < 128) { tr_item(I.w_router, 256, 0, W4t, 1024, 0, r / 8, r % 8, scr, F.lane); continue; } r -= 128;
        if (r < 64) { tr_item(I.ws_gate, 256, 0, W4t, 1024, 256, r / 4, r % 4, scr, F.lane); continue; } r -= 64;
        if (r < 64) { tr_item(I.ws_up, 256, 0, W4t, 1024, 384, r / 4, r % 4, scr, F.lane); continue; } r -= 64;
        if (r < 64) { tr_item(I.ws_gate, 256, 128, W4t, 1024, 512, r / 4, r % 4, scr, F.lane); continue; } r -= 64;
        if (r < 64) { tr_item(I.ws_up, 256, 128, W4t, 1024, 640, r / 4, r % 4, scr, F.lane); continue; } r -= 64;
        tr_item(I.ws_down, 1024, 0, Wsdt, 256, 0, r / 32, r % 32, scr, F.lane);
    }
    for (int idx = F.vcu * NTHREADS + F.tid; idx < M * 8; idx += F.G * NTHREADS) {
        const int row = idx >> 3, i = idx & 7;
        const float inv_freq = powf(500000.0f, -(float)(2 * i) / 16.0f);
        const float ang = (float)I.positions[row] * inv_freq;
        CS[row * 16 + i] = cosf(ang); CS[row * 16 + 8 + i] = sinf(ang);
    }
}

__device__ __forceinline__ void norm_rows(Frame& F, const float* x, const float* g, int sh_off, int sc_off, bf16* XN) {
    const float* mod = (const float*)(F.ws + WS_MOD);
    const int gw = F.vcu * NWAVES + F.wave, NGW = F.G * NWAVES;
    for (int m = gw; m < M; m += NGW) {
        const GAS f32x4* xr = (const GAS f32x4*)(x + (size_t)m * D) + F.lane;
        f32x4 v[4]; float s = 0.f;
#pragma unroll
        for (int j = 0; j < 4; ++j) { v[j] = xr[64 * j]; s += (v[j].x * v[j].x + v[j].y * v[j].y) + (v[j].z * v[j].z + v[j].w * v[j].w); }
        const float r = rsqrtf(wave_sum(s) * (1.f / D) + EPS);
        const float* mb = mod + (m >> 13) * 6144;
        GAS unsigned long long* o8 = (GAS unsigned long long*)(XN + (size_t)m * D) + F.lane;
#pragma unroll
        for (int j = 0; j < 4; ++j) { const int c = 4 * F.lane + 256 * j;
            const f32x4 gg = *(const f32x4*)(g + c), sc = *(const f32x4*)(mb + sc_off + c), sh = *(const f32x4*)(mb + sh_off + c);
            const f32x4 o = v[j] * r * gg * (sc + 1.0f) + sh;
            o8[64 * j] = (unsigned long long)pk2(o.x, o.y) | ((unsigned long long)pk2(o.z, o.w) << 32); }
    }
}

struct EpiP1 {
    static constexpr bool PERM = true, AFTER_DRAIN = false;
    unsigned char* ws; const float* b_gk;
    __device__ __forceinline__ void operator()(const pg8::f32x4 (&acc)[2][2][4][2], const pg8::Unit& u, int wr, int wc, int fr, int fq) const {
        const int row0 = u.pm * 256 + wr * 64 + fr, cl0 = wc * 32 + 8 * fq, pn = u.pn;
        if (pn == 4) {
            float* LA = (float*)(ws + WS_LA);
#pragma unroll
            for (int bj = 0; bj < 2; ++bj) {
                const int col = bj * 128 + cl0;
                const f32x4 b0 = *(const f32x4*)(b_gk + col), b1 = *(const f32x4*)(b_gk + col + 4);
#pragma unroll
                for (int ai = 0; ai < 2; ++ai)
#pragma unroll
                    for (int m = 0; m < 4; ++m) {
                        const f32x4 z0 = acc[ai][bj][m][0] + b0, z1 = acc[ai][bj][m][1] + b1; f32x4 o0, o1;
#pragma unroll
                        for (int i = 0; i < 4; ++i) { o0[i] = (fminf(z0[i], 0.f) - log1pf(__expf(-fabsf(z0[i])))) * 0.0625f; o1[i] = (fminf(z1[i], 0.f) - log1pf(__expf(-fabsf(z1[i])))) * 0.0625f; }
                        float* dst = LA + (size_t)(row0 + ai * 128 + m * 16) * 256 + col;
                        *(f32x4*)dst = o0; *(f32x4*)(dst + 4) = o1;
                    }
            }
            return;
        }
        size_t boff; int ld, bjs = 128, mode = 0; float scale = 1.f;
        if (pn == 0) { boff = WS_GQ; ld = 256; scale = 0.125f; }
        else if (pn == 1) { boff = WS_GK; ld = 256; }
        else if (pn < 4) { boff = WS_GV + (size_t)(pn - 2) * 512; ld = 512; }
        else if (pn < 7) { boff = WS_SGR + (size_t)(pn - 5) * 512; ld = 512; mode = 1; }
        else if (pn < 9) { boff = WS_SQ + (size_t)(pn - 7) * 512; ld = 512; mode = 2; scale = QS; }
        else { boff = WS_SK; ld = 128; bjs = (int)((WS_SV - WS_SK) / 2); mode = 3; }
        bf16* base = (bf16*)(ws + boff) + cl0;
        const bool ropewave = (mode >= 2) && ((wc & 1) == 0);
        const float* CS = (const float*)(ws + WS_CS);
#pragma unroll
        for (int ai = 0; ai < 2; ++ai)
#pragma unroll
            for (int m = 0; m < 4; ++m) {
                const int row = row0 + ai * 128 + m * 16;
                f32x4 cs0, cs1, sn0, sn1;
                if (ropewave) { const f32x4* cp = (const f32x4*)(CS + (size_t)row * 16); cs0 = cp[0]; cs1 = cp[1]; sn0 = cp[2]; sn1 = cp[3]; }
#pragma unroll
                for (int bj = 0; bj < 2; ++bj) {
                    f32x4 v0 = acc[ai][bj][m][0], v1 = acc[ai][bj][m][1];
                    if (mode == 1) {
#pragma unroll
                        for (int i = 0; i < 4; ++i) { v0[i] = siluf(v0[i]); v1[i] = siluf(v1[i]); }
                    }
                    if (ropewave && (mode == 2 || bj == 0)) {
                        f32x4 p0, p1;
#pragma unroll
                        for (int i = 0; i < 4; ++i) { p0[i] = __shfl_xor(v0[i], 16); p1[i] = __shfl_xor(v1[i], 16); }
                        if (fq == 0) { v0 = v0 * cs0 - p0 * sn0; v1 = v1 * cs1 - p1 * sn1; }
                        else if (fq == 1) { v0 = v0 * cs0 + p0 * sn0; v1 = v1 * cs1 + p1 * sn1; }
                    }
                    v0 = v0 * scale; v1 = v1 * scale;
                    pg8::u32x4 w; w.x = pg8::cvt_pk_bf16(v0[0], v0[1]); w.y = pg8::cvt_pk_bf16(v0[2], v0[3]); w.z = pg8::cvt_pk_bf16(v1[0], v1[1]); w.w = pg8::cvt_pk_bf16(v1[2], v1[3]);
                    *(pg8::u32x4*)(base + (size_t)row * ld + bj * bjs) = w;
                }
            }
    }
};
struct EpiXmid {
    static constexpr bool PERM = false, AFTER_DRAIN = false;
    const float* x; const float* mod; float* xmid;
    __device__ __forceinline__ void operator()(const pg8::f32x4 (&acc)[2][2][4][2], const pg8::Unit& u, int wr, int wc, int fr, int fq) const {
        const int row0 = u.pm * 256 + wr * 64 + fr, col0 = u.pn * 256 + wc * 32 + 4 * fq;
        const float* gt = mod + (u.pm >> 5) * 6144 + 2048;
        pg8::f32x4 gv[2][2];
#pragma unroll
        for (int bj = 0; bj < 2; ++bj)
#pragma unroll
            for (int n = 0; n < 2; ++n) gv[bj][n] = *(const pg8::f32x4*)(gt + col0 + bj * 128 + n * 16);
#pragma unroll
        for (int ai = 0; ai < 2; ++ai)
#pragma unroll
            for (int m = 0; m < 4; ++m) { const size_t off = (size_t)(row0 + ai * 128 + m * 16) * D + col0;
#pragma unroll
                for (int bj = 0; bj < 2; ++bj)
#pragma unroll
                    for (int n = 0; n < 2; ++n) { const pg8::f32x4 xv = *(const pg8::f32x4*)(x + off + bj * 128 + n * 16);
                        *(pg8::f32x4*)(xmid + off + bj * 128 + n * 16) = xv + gv[bj][n] * acc[ai][bj][m][n]; } }
    }
};
struct EpiP4 {
    static constexpr bool PERM = true, AFTER_DRAIN = false;
    float* logits; bf16* sact;
    __device__ __forceinline__ void operator()(const pg8::f32x4 (&acc)[2][2][4][2], const pg8::Unit& u, int wr, int wc, int fr, int fq) const {
        const int row0 = u.pm * 256 + wr * 64 + fr, cl0 = wc * 32 + 8 * fq;
#pragma unroll
        for (int ai = 0; ai < 2; ++ai)
#pragma unroll
            for (int m = 0; m < 4; ++m) { const int row = row0 + ai * 128 + m * 16;
                if (u.pn == 0) {
#pragma unroll
                    for (int bj = 0; bj < 2; ++bj) { float* dst = logits + (size_t)row * 256 + bj * 128 + cl0; *(pg8::f32x4*)dst = acc[ai][bj][m][0]; *(pg8::f32x4*)(dst + 4) = acc[ai][bj][m][1]; }
                } else {
                    pg8::f32x4 a0 = acc[ai][0][m][0], a1 = acc[ai][0][m][1]; const pg8::f32x4 u0 = acc[ai][1][m][0], u1 = acc[ai][1][m][1];
#pragma unroll
                    for (int i = 0; i < 4; ++i) { a0[i] = siluf(a0[i]) * u0[i]; a1[i] = siluf(a1[i]) * u1[i]; }
                    pg8::u32x4 w; w.x = pg8::cvt_pk_bf16(a0[0], a0[1]); w.y = pg8::cvt_pk_bf16(a0[2], a0[3]); w.z = pg8::cvt_pk_bf16(a1[0], a1[1]); w.w = pg8::cvt_pk_bf16(a1[2], a1[3]);
                    *(pg8::u32x4*)(sact + (size_t)row * 256 + (u.pn - 1) * 128 + cl0) = w;
                }
            }
    }
};
struct EpiF32x {
    static constexpr bool PERM = false, AFTER_DRAIN = false;
    float* C; int ldc;
    __device__ __forceinline__ void operator()(const pg8::f32x4 (&acc)[2][2][4][2], const pg8::Unit& u, int wr, int wc, int fr, int fq) const {
        const int row0 = u.pm * 256 + wr * 64 + fr, col0 = u.pn * 256 + wc * 32 + 4 * fq;
#pragma unroll
        for (int ai = 0; ai < 2; ++ai)
#pragma unroll
            for (int m = 0; m < 4; ++m) { float* rowp = C + (size_t)(row0 + ai * 128 + m * 16) * ldc + col0;
#pragma unroll
                for (int bj = 0; bj < 2; ++bj)
#pragma unroll
                    for (int n = 0; n < 2; ++n) *(pg8::f32x4*)(rowp + bj * 128 + n * 16) = acc[ai][bj][m][n]; }
    }
};

__device__ __forceinline__ void route_tokens(Frame& F, const float* logits, const float* rbias, int* cnt, int* list, float* wts) {
    const int gw = F.vcu * NWAVES + F.wave, NGW = F.G * NWAVES, lane = F.lane;
    const f32x4 rb = *(const f32x4*)(rbias + lane * 4);
    for (int t = gw; t < M; t += NGW) {
        const f32x4 lg = *(const f32x4*)(logits + (size_t)t * 256 + lane * 4);
        const float sc0 = 1.f / (1.f + expf(-lg.x)), sc1 = 1.f / (1.f + expf(-lg.y)), sc2 = 1.f / (1.f + expf(-lg.z)), sc3 = 1.f / (1.f + expf(-lg.w));
        float s0 = sc0 + rb.x, s1 = sc1 + rb.y, s2 = sc2 + rb.z, s3 = sc3 + rb.w;
        float m1 = fmaxf(s0, s1), m2 = fminf(s0, s1);
        { const float n1 = fmaxf(m1, s2), n2 = fmaxf(fminf(m1, s2), m2); m1 = n1; m2 = n2; }
        { const float n1 = fmaxf(m1, s3), n2 = fmaxf(fminf(m1, s3), m2); m1 = n1; m2 = n2; }
#pragma unroll
        for (int off = 1; off < 8; off <<= 1) {
            const float o1 = __shfl_xor(m1, off), o2 = __shfl_xor(m2, off);
            const float n1 = fmaxf(m1, o1), n2 = fmaxf(fminf(m1, o1), fmaxf(m2, o2)); m1 = n1; m2 = n2;
        }
        const float gs = m1 + m2; const int myg = lane >> 3;
        int rank = 0;
#pragma unroll
        for (int j = 0; j < 8; ++j) { const float gj = __shfl(gs, j * 8); rank += (gj > gs || (gj == gs && j < myg)) ? 1 : 0; }
        if (rank >= 4) { s0 = -INFINITY; s1 = -INFINITY; s2 = -INFINITY; s3 = -INFINITY; }
        float wsum = 0.f, my_s = 0.f; int my_e = 0;
#pragma unroll
        for (int k = 0; k < 8; ++k) {
            float bv = s0; int bi = 0;
            if (s1 > bv) { bv = s1; bi = 1; }
            if (s2 > bv) { bv = s2; bi = 2; }
            if (s3 > bv) { bv = s3; bi = 3; }
            float v = bv; int e = lane * 4 + bi;
#pragma unroll
            for (int off = 32; off >= 1; off >>= 1) {
                const float ov = __shfl_xor(v, off); const int oe = __shfl_xor(e, off);
                if (ov > v || (ov == v && oe < e)) { v = ov; e = oe; }
            }
            const int ei = e & 3;
            const float mysc = ei == 0 ? sc0 : ei == 1 ? sc1 : ei == 2 ? sc2 : sc3;
            const float scw = __shfl(mysc, e >> 2);
            if (lane == (e >> 2)) { if (ei == 0) s0 = -INFINITY; else if (ei == 1) s1 = -INFINITY; else if (ei == 2) s2 = -INFINITY; else s3 = -INFINITY; }
            if (lane == k) { my_e = e; my_s = scw; }
            wsum += scw;
        }
        if (lane < 8) {
            const float w = my_s / wsum * 2.5f;
            const int pos = atomicAdd(&cnt[my_e], 1);
            list[my_e * CAP + pos] = t * 8 + lane;
            wts[t * 8 + lane] = w;
        }
    }
}

__device__ __forceinline__ void final_rows(Frame& F, const float* xmid, const float* shout, const float* routed, const float* g, float* out) {
    const float* mod = (const float*)(F.ws + WS_MOD);
    const int gw = F.vcu * NWAVES + F.wave, NGW = F.G * NWAVES;
    for (int m = gw; m < M; m += NGW) {
        const size_t ro = (size_t)m * D;
        const float* gt = mod + (m >> 13) * 6144 + 5120;
        f32x4 v[4]; float s = 0.f;
#pragma unroll
        for (int j = 0; j < 4; ++j) { const int c = 4 * F.lane + 256 * j;
            const f32x4 xv = *(const f32x4*)(xmid + ro + c), sv = *(const f32x4*)(shout + ro + c), rv = *(const f32x4*)(routed + ro + c), gg = *(const f32x4*)(gt + c);
            v[j] = xv + gg * (sv + rv); s += (v[j].x * v[j].x + v[j].y * v[j].y) + (v[j].z * v[j].z + v[j].w * v[j].w); }
        const float r = rsqrtf(wave_sum(s) * (1.f / D) + EPS);
#pragma unroll
        for (int j = 0; j < 4; ++j) { const int c = 4 * F.lane + 256 * j; const f32x4 gf = *(const f32x4*)(g + c); *(f32x4*)(out + ro + c) = v[j] * r * gf; }
    }
}

struct RowBf16 { const bf16* base; const int* lst; int lda;
    __device__ __forceinline__ const bf16* operator()(int r) const { return base + (size_t)(lst ? (lst[r] >> 3) : r) * lda; } };
struct RowF32 { const float* base; int lda; __device__ __forceinline__ const float* operator()(int r) const { return base + (size_t)r * lda; } };
__device__ __forceinline__ f32x4 ld4(const float* p) { return *(const f32x4*)p; }
__device__ __forceinline__ f32x4 ld4(const bf16* p) { const unsigned long long w = *(const unsigned long long*)p;
    return (f32x4){bf2f((unsigned short)w), bf2f((unsigned short)(w >> 16)), bf2f((unsigned short)(w >> 32)), bf2f((unsigned short)(w >> 48))}; }
template <class ARow, class Epi>
__device__ __forceinline__ void fma_tile64(LAS unsigned char* ldsb, const ARow& arow, int mvalid, const float* __restrict__ Bm, int ldb, int n0, int K, const Epi& epi) {
    const int tid = threadIdx.x & 255, tx = tid & 15, ty = tid >> 4;
    LAS float* As = (LAS float*)(ldsb + (threadIdx.x >> 8) * 8704);
    LAS float* Bs = As + 16 * 68;
    float acc[4][4];
#pragma unroll
    for (int i = 0; i < 4; ++i)
#pragma unroll
        for (int j = 0; j < 4; ++j) acc[i][j] = 0.f;
    const int ar = tid >> 2, akq = (tid & 3) * 4, bk = tid >> 4, bnq = (tid & 15) * 4;
    const bool av_ok = ar < mvalid;
    for (int k0 = 0; k0 < K; k0 += 16) {
        f32x4 av = (f32x4){0.f, 0.f, 0.f, 0.f};
        if (av_ok) av = ld4(arow(ar) + k0 + akq);
        As[(akq + 0) * 68 + ar] = av.x; As[(akq + 1) * 68 + ar] = av.y; As[(akq + 2) * 68 + ar] = av.z; As[(akq + 3) * 68 + ar] = av.w;
        const f32x4 bv = *(const f32x4*)(Bm + (size_t)(k0 + bk) * ldb + n0 + bnq);
        *(LAS f32x4*)(Bs + bk * 68 + bnq) = bv;
        __syncthreads();
#pragma unroll
        for (int k = 0; k < 16; ++k) {
            const f32x4 a = *(const LAS f32x4*)(As + k * 68 + ty * 4);
            const f32x4 b = *(const LAS f32x4*)(Bs + k * 68 + tx * 4);
#pragma unroll
            for (int i = 0; i < 4; ++i)
#pragma unroll
                for (int j = 0; j < 4; ++j) acc[i][j] += a[i] * b[j];
        }
        __syncthreads();
    }
#pragma unroll
    for (int i = 0; i < 4; ++i)
#pragma unroll
        for (int j = 0; j < 4; ++j) { const int r = ty * 4 + i; if (r < mvalid) epi(r, n0 + tx * 4 + j, acc[i][j]); }
}
struct MoeMap { LAS int* cnt; LAS int* offs; LAS int* toff; };
__device__ __forceinline__ MoeMap moe_map_build(Frame& F, const int* cnt_g, int tile_rows) {
    MoeMap mm; mm.cnt = (LAS int*)(F.lds + RING_OFF + 2 * 8704); mm.offs = mm.cnt + 260; mm.toff = mm.offs + 260;
    if (F.tid < NE) mm.cnt[F.tid] = cnt_g[F.tid];
    LDS_WAIT(); __syncthreads();
    if (F.tid == 0) { int a = 0, b = 0; for (int e = 0; e < NE; ++e) { mm.offs[e] = a; mm.toff[e] = b; a += mm.cnt[e]; b += (mm.cnt[e] + tile_rows - 1) / tile_rows; } mm.offs[NE] = a; mm.toff[NE] = b; }
    LDS_WAIT(); __syncthreads();
    return mm;
}
__device__ __forceinline__ void moe_find(const MoeMap& mm, int tile, int& e, int& tl) {
    int lo = 0, hi = NE;
    while (hi - lo > 1) { const int mid = (lo + hi) >> 1; if (mm.toff[mid] <= tile) lo = mid; else hi = mid; }
    e = lo; tl = tile - mm.toff[lo];
}
struct EpiActF { float* G; int first; __device__ __forceinline__ void operator()(int r, int c, float v) const { float* p = G + (size_t)r * 256 + c; if (first) *p = v; else *p = siluf(*p) * v; } };
struct EpiScatterF { float* routed; const int* lst; const float* wts; __device__ __forceinline__ void operator()(int r, int c, float v) const { const int en = lst[r]; atomicAdd(routed + (size_t)(en >> 3) * D + c, wts[en] * v); } };
__device__ __forceinline__ void moe_simple_gu(Frame& F, const bf16* H2, const float* w_gate, const float* w_up, const int* cnt_g, const int* list, float* gbuf) {
    const MoeMap mm = moe_map_build(F, cnt_g, 64);
    const int ntiles = mm.toff[NE], nunits = ntiles * 4, sub = F.tid >> 8;
    for (int u0 = F.vcu * 2; u0 < nunits; u0 += F.G * 2) {
        const int u = u0 + sub; const bool ok = u < nunits;
        int e = 0, tl = 0; if (ok) moe_find(mm, u >> 2, e, tl);
        const int n0 = (u & 3) * 64, mvalid = ok ? min(64, mm.cnt[e] - tl * 64) : 0;
        RowBf16 ar{H2, list + (size_t)e * CAP + tl * 64, D};
        float* G = gbuf + (size_t)(mm.offs[e] + tl * 64) * 256;
        fma_tile64(F.lds + RING_OFF, ar, mvalid, w_gate + (size_t)e * D * 256, 256, n0, D, EpiActF{G, 1});
        fma_tile64(F.lds + RING_OFF, ar, mvalid, w_up + (size_t)e * D * 256, 256, n0, D, EpiActF{G, 0});
    }
}
__device__ __forceinline__ void moe_simple_down(Frame& F, const float* gbuf, const float* w_down, const int* cnt_g, const int* list, const float* wts, float* routed) {
    const MoeMap mm = moe_map_build(F, cnt_g, 64);
    const int ntiles = mm.toff[NE], nunits = ntiles * 16, sub = F.tid >> 8;
    for (int u0 = F.vcu * 2; u0 < nunits; u0 += F.G * 2) {
        const int u = u0 + sub; const bool ok = u < nunits;
        int e = 0, tl = 0; if (ok) moe_find(mm, u >> 4, e, tl);
        const int n0 = (u & 15) * 64, mvalid = ok ? min(64, mm.cnt[e] - tl * 64) : 0;
        RowF32 ar{gbuf + (size_t)(mm.offs[e] + tl * 64) * 256, 256};
        fma_tile64(F.lds + RING_OFF, ar, mvalid, w_down + (size_t)e * 256 * D, D, n0, 256, EpiScatterF{routed, list + (size_t)e * CAP + tl * 64, wts});
    }
}
__device__ __forceinline__ void swa_simple(Frame& F, int gw0, int ngw, const bf16* SQ, const bf16* SK, const bf16* SV, const float* sinks, bf16* OMIX) {
    for (int blk = gw0; blk < 2 * 8 * (SEQ / 64); blk += ngw) {
        const int tb = blk % (SEQ / 64), h = (blk / (SEQ / 64)) % 8, b = blk / (SEQ / 64 * 8);
        const int t0 = tb * 64, t = t0 + F.lane, kvh = h >> 2;
        float q[64], o[64];
        const bf16* qp = SQ + ((size_t)b * SEQ + t) * 512 + h * 64;
#pragma unroll
        for (int d = 0; d < 64; ++d) { q[d] = bf2f(qp[d]); o[d] = 0.f; }
        float m = sinks[h] * LOG2E, l = 1.f;
        const int jlo = max(0, t0 - 127);
        for (int j = jlo; j <= t0 + 63; ++j) {
            const bf16* kp = SK + ((size_t)b * SEQ + j) * 128 + kvh * 64;
            const bf16* vp = SV + ((size_t)b * SEQ + j) * 128 + kvh * 64;
            float s = 0.f;
#pragma unroll
            for (int d = 0; d < 64; ++d) s += q[d] * bf2f(kp[d]);
            const bool valid = (j <= t) && (j >= t - 127);
            if (!valid) s = -INFINITY;
            if (s > m) {
                const float sc = exp2f(m - s); l *= sc;
#pragma unroll
                for (int d = 0; d < 64; ++d) o[d] *= sc;
                m = s;
            }
            const float p = exp2f(s - m); l += p;
#pragma unroll
            for (int d = 0; d < 64; ++d) o[d] += p * bf2f(vp[d]);
        }
        const float il = 1.f / l;
        bf16* op = OMIX + ((size_t)b * SEQ + t) * 1024 + 512 + h * 64;
#pragma unroll
        for (int d = 0; d < 64; ++d) op[d] = (bf16)f2bf(o[d] * il);
    }
}
__device__ __forceinline__ void gla_rec_simple(Frame& F, int bh, const bf16* GQ, const bf16* GK, const bf16* GV, const float* LA, float* og) {
    const int b = bh >> 2, h = bh & 3, dv = F.tid & 127;
    LAS float* sq = (LAS float*)(F.lds + RING_OFF); LAS float* sk = sq + 2048; LAS float* sa = sk + 2048; LAS float* sv = sa + 2048;
    float St[64];
#pragma unroll
    for (int d = 0; d < 64; ++d) St[d] = 0.f;
    for (int t0 = 0; t0 < SEQ; t0 += 32) {
        for (int i = F.tid; i < 2048; i += NTHREADS) {
            const int tt = i >> 6, d = i & 63; const size_t row = (size_t)b * SEQ + t0 + tt;
            sq[i] = bf2f(GQ[row * 256 + h * 64 + d]); sk[i] = bf2f(GK[row * 256 + h * 64 + d]); sa[i] = expf(LA[row * 256 + h * 64 + d]);
        }
        for (int i = F.tid; i < 4096; i += NTHREADS) {
            const int tt = i >> 7, d = i & 127; const size_t row = (size_t)b * SEQ + t0 + tt;
            sv[i] = bf2f(GV[row * 512 + h * 128 + d]);
        }
        LDS_WAIT(); __syncthreads();
        if (F.tid < 128) {
            for (int tt = 0; tt < 32; ++tt) {
                const float v = sv[tt * 128 + dv];
                float o = 0.f;
#pragma unroll
                for (int d = 0; d < 64; ++d) { St[d] = sa[tt * 64 + d] * St[d] + sk[tt * 64 + d] * v; o += sq[tt * 64 + d] * St[d]; }
                og[((size_t)b * SEQ + t0 + tt) * 512 + h * 128 + dv] = o;
            }
        }
        LDS_WAIT(); __syncthreads();
    }
}
__device__ __forceinline__ void gla_out_simple(Frame& F, const float* og, const bf16* SGR, const float* g_out, bf16* OMIX) {
    const int gw = F.vcu * NWAVES + F.wave, NGW = F.G * NWAVES, lane = F.lane;
    for (int w = gw; w < M * 4; w += NGW) {
        const size_t row = (size_t)(w >> 2); const int h = w & 3;
        const float a = og[row * 512 + h * 128 + lane], b = og[row * 512 + h * 128 + 64 + lane];
        const float r = rsqrtf(wave_sum(a * a + b * b) * (1.f / 128.f) + EPS);
        const float ga = bf2f(SGR[row * 512 + h * 128 + lane]), gb = bf2f(SGR[row * 512 + h * 128 + 64 + lane]);
        OMIX[row * 1024 + h * 128 + lane] = (bf16)f2bf(a * r * g_out[lane] * ga);
        OMIX[row * 1024 + h * 128 + 64 + lane] = (bf16)f2bf(b * r * g_out[64 + lane] * gb);
    }
}
namespace moe {
constexpr int A_BYTES = 256 * 64, B_KG = 2240, B_BYTES = 8 * B_KG;
constexpr int OFF_A = 0, OFF_B = 2 * A_BYTES, OFF_ROW = OFF_B + 2 * B_BYTES, OFF_MAP = OFF_ROW + 2048, LDS_END = OFF_MAP + 3 * 260 * 4;
static_assert(LDS_END <= RING_BYTES, "moe LDS");
typedef short bf16x8 __attribute__((ext_vector_type(8)));
typedef short s16x4 __attribute__((ext_vector_type(4)));
typedef unsigned u32x2 __attribute__((ext_vector_type(2)));

struct Ctx { const bf16* H2; const float *wg, *wu, *wd; const int* list; const float* wts; bf16* ACT; bf16* SLOT; };

__device__ __forceinline__ void unit(Frame& F, const Ctx& C, int e, int mt, int cnt_e, int pos0) {
    LAS unsigned char* L = F.lds + RING_OFF;
    LAS int* rowent = (LAS int*)(L + OFF_ROW); LAS float* roww = (LAS float*)(L + OFF_ROW + 1024);
    const int tid = F.tid, lane = F.lane, wid = F.wave, wr = wid >> 2, wc = wid & 3, fr = lane & 15, fq = lane >> 4;
    const int mvalid = min(256, cnt_e - mt * 256);
    if (tid < 256) { const int ent = (tid < mvalid) ? C.list[(size_t)e * CAP + mt * 256 + tid] : -1; rowent[tid] = ent; roww[tid] = ent >= 0 ? C.wts[ent] : 0.f; }
    LDS_WAIT(); __syncthreads();
    const int ar0 = tid >> 2, ac = tid & 3;
    int tokA[2], rowA[2];
#pragma unroll
    for (int j = 0; j < 2; ++j) { const int r = ar0 + 128 * j; int ent = rowent[r]; if (ent < 0) ent = rowent[0]; tokA[j] = ent >> 3; rowA[j] = min(r, mvalid - 1); }
    unsigned aw_off[2];
#pragma unroll
    for (int j = 0; j < 2; ++j) { const int r = ar0 + 128 * j; aw_off[j] = (unsigned)(r * 64 + ((ac ^ ((0 - (r >> 2)) & 3)) * 16)); }
    const int hb = lane >> 5, l5 = lane & 31;
    const unsigned bw_off = (unsigned)(wid * B_KG + (32 * hb + 8 * (l5 >> 3) + 4 * (l5 & 1) + ((l5 >> 1) & 3)) * 8);
    const unsigned ar_off = (unsigned)((64 * wr + fr) * 64 + ((fq ^ ((0 - (fr >> 2)) & 3)) * 16));
    const unsigned br_off = (unsigned)(2 * fq * B_KG + (fr & 3) * 544 + (8 * wc + (fr >> 2)) * 8);

    for (int pass = 0; pass < 6; ++pass) {
        const bool s1 = pass < 2;
        const int nsteps = s1 ? 32 : 8;
        const bf16* ap[2]; const float* bp; int ldb;
        if (s1) { ap[0] = C.H2 + (size_t)tokA[0] * D + ac * 8; ap[1] = C.H2 + (size_t)tokA[1] * D + ac * 8;
                  bp = (hb ? C.wu : C.wg) + (size_t)e * D * 256 + pass * 128 + 4 * l5 + (size_t)(4 * wid) * 256; ldb = 256; }
        else { ap[0] = C.ACT + (size_t)(pos0 + rowA[0]) * 256 + ac * 8; ap[1] = C.ACT + (size_t)(pos0 + rowA[1]) * 256 + ac * 8;
               bp = C.wd + (size_t)e * 256 * D + (pass - 2) * 256 + hb * 128 + 4 * l5 + (size_t)(4 * wid) * D; ldb = D; }
        f32x4 acc[2][2][4][2];
#pragma unroll
        for (int a = 0; a < 2; ++a)
#pragma unroll
            for (int b = 0; b < 2; ++b)
#pragma unroll
                for (int m = 0; m < 4; ++m)
#pragma unroll
                    for (int n = 0; n < 2; ++n) acc[a][b][m][n] = (f32x4){0.f, 0.f, 0.f, 0.f};
        v4u ra[2]; f32x4 rb[4];
#define MOE_LOAD(t) do { const int t_ = (t); \
            ra[0] = *(const v4u*)(ap[0] + t_ * 32); ra[1] = *(const v4u*)(ap[1] + t_ * 32); \
            _Pragma("unroll") for (int kk = 0; kk < 4; ++kk) rb[kk] = *(const f32x4*)(bp + (size_t)(t_ * 32 + kk) * ldb); } while (0)
#define MOE_WRITE(buf) do { LAS unsigned char* Ab = L + OFF_A + (buf) * A_BYTES; LAS unsigned char* Bb = L + OFF_B + (buf) * B_BYTES; \
            *(LAS v4u*)(Ab + aw_off[0]) = ra[0]; *(LAS v4u*)(Ab + aw_off[1]) = ra[1]; \
            _Pragma("unroll") for (int i = 0; i < 4; ++i) { u32x2 w; w.x = pk2(rb[0][i], rb[1][i]); w.y = pk2(rb[2][i], rb[3][i]); *(LAS u32x2*)(Bb + bw_off + i * 544) = w; } } while (0)
        MOE_LOAD(0); MOE_WRITE(0);
        LDS_WAIT(); __syncthreads();
        for (int t = 0; t < nsteps; ++t) {
            const int tn = (t + 1 < nsteps) ? t + 1 : t;
            MOE_LOAD(tn);
            const LAS unsigned char* Ab = L + OFF_A + (t & 1) * A_BYTES + ar_off; const LAS unsigned char* Bb = L + OFF_B + (t & 1) * B_BYTES + br_off;
            bf16x8 bf[2][2];
#pragma unroll
            for (int bj = 0; bj < 2; ++bj)
#pragma unroll
                for (int n = 0; n < 2; ++n) { const s16x4 lo = *(const LAS s16x4*)(Bb + bj * 256 + n * 32), hi = *(const LAS s16x4*)(Bb + bj * 256 + n * 32 + B_KG);
                    bf[bj][n] = (bf16x8){lo[0], lo[1], lo[2], lo[3], hi[0], hi[1], hi[2], hi[3]}; }
#pragma unroll
            for (int ai = 0; ai < 2; ++ai) {
                bf16x8 af[4];
#pragma unroll
                for (int m = 0; m < 4; ++m) af[m] = *(const LAS bf16x8*)(Ab + (128 * ai + 16 * m) * 64);
#pragma unroll
                for (int m = 0; m < 4; ++m)
#pragma unroll
                    for (int bj = 0; bj < 2; ++bj)
#pragma unroll
                        for (int n = 0; n < 2; ++n) acc[ai][bj][m][n] = __builtin_amdgcn_mfma_f32_16x16x32_bf16(bf[bj][n], af[m], acc[ai][bj][m][n], 0, 0, 0);
            }
            MOE_WRITE((t + 1) & 1);
            LDS_WAIT(); __syncthreads();
        }
#undef MOE_LOAD
#undef MOE_WRITE
        const int cl0 = 32 * wc + 8 * fq;
#pragma unroll
        for (int ai = 0; ai < 2; ++ai)
#pragma unroll
            for (int m = 0; m < 4; ++m) {
                const int r = 128 * ai + 64 * wr + 16 * m + fr;
                if (r < mvalid) {
                    if (s1) {
                        f32x4 a0 = acc[ai][0][m][0], a1 = acc[ai][0][m][1]; const f32x4 u0 = acc[ai][1][m][0], u1 = acc[ai][1][m][1];
#pragma unroll
                        for (int i = 0; i < 4; ++i) { a0[i] = siluf(a0[i]) * u0[i]; a1[i] = siluf(a1[i]) * u1[i]; }
                        v4u w; w.x = pk2(a0[0], a0[1]); w.y = pk2(a0[2], a0[3]); w.z = pk2(a1[0], a1[1]); w.w = pk2(a1[2], a1[3]);
                        *(v4u*)(C.ACT + (size_t)(pos0 + r) * 256 + pass * 128 + cl0) = w;
                    } else {
                        const float wgt = roww[r]; bf16* dst = C.SLOT + (size_t)rowent[r] * D + (pass - 2) * 256 + cl0;
#pragma unroll
                        for (int bj = 0; bj < 2; ++bj) { const f32x4 a0 = acc[ai][bj][m][0] * wgt, a1 = acc[ai][bj][m][1] * wgt;
                            v4u w; w.x = pk2(a0[0], a0[1]); w.y = pk2(a0[2], a0[3]); w.z = pk2(a1[0], a1[1]); w.w = pk2(a1[2], a1[3]);
                            *(v4u*)(dst + bj * 128) = w; }
                    }
                }
            }
        if (pass == 1) { VM_WAIT(); __syncthreads(); }
    }
    __syncthreads();
}

__device__ __forceinline__ void phase(Frame& F, const Ctx& C, const int* cnt_g) {
    LAS unsigned char* L = F.lds + RING_OFF;
    LAS int* cnt = (LAS int*)(L + OFF_MAP); LAS int* offs = cnt + 260; LAS int* toff = offs + 260;
    if (F.tid < NE) cnt[F.tid] = cnt_g[F.tid];
    LDS_WAIT(); __syncthreads();
    if (F.tid == 0) { int a = 0, b = 0; for (int e = 0; e < NE; ++e) { offs[e] = a; toff[e] = b; a += cnt[e]; b += (cnt[e] + 255) >> 8; } offs[NE] = a; toff[NE] = b; }
    LDS_WAIT(); __syncthreads();
    const int nunits = toff[NE];
    for (int u = F.vcu; u < nunits; u += F.G) {
        int lo = 0, hi = NE;
        while (hi - lo > 1) { const int mid = (lo + hi) >> 1; if (toff[mid] <= u) lo = mid; else hi = mid; }
        const int e = lo, mt = u - toff[lo];
        unit(F, C, e, mt, cnt[e], offs[e] + mt * 256);
    }
}
}

__device__ __forceinline__ void final_rows_slots(Frame& F, const float* xmid, const float* shout, const bf16* SLOT, const float* g, float* out) {
    const float* mod = (const float*)(F.ws + WS_MOD);
    const int gw = F.vcu * NWAVES + F.wave, NGW = F.G * NWAVES;
    for (int m = gw; m < M; m += NGW) {
        const size_t ro = (size_t)m * D;
        const float* gt = mod + (m >> 13) * 6144 + 5120;
        f32x4 v[4]; float s = 0.f;
#pragma unroll
        for (int j = 0; j < 4; ++j) { const int c = 4 * F.lane + 256 * j;
            f32x4 acc = *(const f32x4*)(shout + ro + c);
#pragma unroll
            for (int k = 0; k < 8; ++k) acc = acc + ld4(SLOT + ((size_t)m * 8 + k) * D + c);
            const f32x4 xv = *(const f32x4*)(xmid + ro + c), gg = *(const f32x4*)(gt + c);
            v[j] = xv + gg * acc; s += (v[j].x * v[j].x + v[j].y * v[j].y) + (v[j].z * v[j].z + v[j].w * v[j].w); }
        const float r = rsqrtf(wave_sum(s) * (1.f / D) + EPS);
#pragma unroll
        for (int j = 0; j < 4; ++j) { const int c = 4 * F.lane + 256 * j; const f32x4 gf = *(const f32x4*)(g + c); *(f32x4*)(out + ro + c) = v[j] * r * gf; }
    }
}
namespace gla {
typedef short bf16x8 __attribute__((ext_vector_type(8)));
typedef short s16x4 __attribute__((ext_vector_type(4)));
typedef unsigned u32x2 __attribute__((ext_vector_type(2)));
constexpr int LDW = 144;
constexpr int OFF_Q2 = 0, OFF_QI = 9216, OFF_KI = 18432, OFF_K2T = 27648, OFF_VT = 36864, OFF_ST = 55296, OFF_T = 73728, OFF_DEC = 75776, OFF_SS = 76032, LDS_END = 76544;
struct Ctx { const bf16 *GQ, *GK, *GV, *SGR; const float* LA; const float* g_out; float* GST; float* GDEC; bf16* OMIX; };

template <bool FULL>
__device__ __forceinline__ void chunk(Frame& F, const Ctx& C, int b, int h, size_t row0, f32x4 (&S)[4], float& sumtot) {
    LAS unsigned char* L = F.lds + RING_OFF;
    const int tid = F.tid, lane = F.lane, w = F.wave, fr = lane & 15, fq = lane >> 4;
    const int d = tid & 63, g = w, dvv = tid & 127, jg = tid >> 7;
    float la[8], kk[8], qq[8]; unsigned short vv[16];
#pragma unroll
    for (int jj = 0; jj < 8; ++jj) { const size_t r = row0 + 8 * g + jj;
        la[jj] = C.LA[r * 256 + h * 64 + d]; kk[jj] = bf2f(C.GK[r * 256 + h * 64 + d]);
        if (FULL) qq[jj] = bf2f(C.GQ[r * 256 + h * 64 + d]); }
#pragma unroll
    for (int jj = 0; jj < 16; ++jj) vv[jj] = C.GV[(row0 + 16 * jg + jj) * 512 + h * 128 + dvv];
#pragma unroll
    for (int jj = 1; jj < 8; ++jj) la[jj] += la[jj - 1];
    LAS float* T = (LAS float*)(L + OFF_T);
    T[g * 64 + d] = la[7];
    LDS_WAIT(); __syncthreads();
    float P = 0.f, tot = 0.f, bref = 0.f;
#pragma unroll
    for (int gg = 0; gg < 8; ++gg) { const float t = T[gg * 64 + d]; if (gg < g) P += t; if (gg < 4) bref += t; tot += t; }
    sumtot += tot;
    {
        unsigned k2w[4];
#pragma unroll
        for (int jj = 0; jj < 8; jj += 2) {
            const float b0 = P + la[jj], b1 = P + la[jj + 1];
            k2w[jj >> 1] = pk2(kk[jj] * __expf(tot - b0), kk[jj + 1] * __expf(tot - b1));
            if (FULL) {
                const int j0 = 8 * g + jj;
                *(LAS unsigned short*)(L + OFF_Q2 + j0 * LDW + d * 2) = (unsigned short)f2bf(qq[jj] * __expf(b0));
                *(LAS unsigned short*)(L + OFF_Q2 + (j0 + 1) * LDW + d * 2) = (unsigned short)f2bf(qq[jj + 1] * __expf(b1));
                *(LAS unsigned short*)(L + OFF_QI + j0 * LDW + d * 2) = (unsigned short)f2bf(qq[jj] * __expf(b0 - bref));
                *(LAS unsigned short*)(L + OFF_QI + (j0 + 1) * LDW + d * 2) = (unsigned short)f2bf(qq[jj + 1] * __expf(b1 - bref));
                *(LAS unsigned short*)(L + OFF_KI + j0 * LDW + d * 2) = (unsigned short)f2bf(kk[jj] * __expf(bref - b0));
                *(LAS unsigned short*)(L + OFF_KI + (j0 + 1) * LDW + d * 2) = (unsigned short)f2bf(kk[jj + 1] * __expf(bref - b1));
            }
        }
        *(LAS v4u*)(L + OFF_K2T + d * LDW + 16 * g) = (v4u){k2w[0], k2w[1], k2w[2], k2w[3]};
        if (g == 0) ((LAS float*)(L + OFF_DEC))[d] = __expf(tot);
        v4u v0, v1;
        v0.x = vv[0] | ((unsigned)vv[1] << 16); v0.y = vv[2] | ((unsigned)vv[3] << 16); v0.z = vv[4] | ((unsigned)vv[5] << 16); v0.w = vv[6] | ((unsigned)vv[7] << 16);
        v1.x = vv[8] | ((unsigned)vv[9] << 16); v1.y = vv[10] | ((unsigned)vv[11] << 16); v1.z = vv[12] | ((unsigned)vv[13] << 16); v1.w = vv[14] | ((unsigned)vv[15] << 16);
        *(LAS v4u*)(L + OFF_VT + dvv * LDW + 32 * jg) = v0; *(LAS v4u*)(L + OFF_VT + dvv * LDW + 32 * jg + 16) = v1;
        if (FULL) {
#pragma unroll
            for (int nt = 0; nt < 4; ++nt) { u32x2 sw; sw.x = pk2(S[nt][0], S[nt][1]); sw.y = pk2(S[nt][2], S[nt][3]);
                *(LAS u32x2*)(L + OFF_ST + (16 * w + fr) * LDW + (16 * nt + 4 * fq) * 2) = sw; }
        }
    }
    LDS_WAIT(); __syncthreads();
    const int it = w >> 1, dvh = w & 1;
    f32x4 dO[4];
    if (FULL) {
        f32x4 dp[4];
#pragma unroll
        for (int nt = 0; nt < 4; ++nt) dp[nt] = (f32x4){0.f, 0.f, 0.f, 0.f};
#pragma unroll
        for (int ks = 0; ks < 2; ++ks) {
            const bf16x8 yq = *(const LAS bf16x8*)(L + OFF_QI + (16 * it + fr) * LDW + (32 * ks + 8 * fq) * 2);
#pragma unroll
            for (int nt = 0; nt < 4; ++nt) { const bf16x8 xk = *(const LAS bf16x8*)(L + OFF_KI + (16 * nt + fr) * LDW + (32 * ks + 8 * fq) * 2);
                dp[nt] = __builtin_amdgcn_mfma_f32_16x16x32_bf16(xk, yq, dp[nt], 0, 0, 0); }
        }
        const int iloc = 16 * it + fr;
#pragma unroll
        for (int nt = 0; nt < 4; ++nt)
#pragma unroll
            for (int r = 0; r < 4; ++r) if (16 * nt + 4 * fq + r > iloc) dp[nt][r] = 0.f;
        bf16x8 yp[2];
#pragma unroll
        for (int ks = 0; ks < 2; ++ks) { v4u pw; pw.x = pk2(dp[2 * ks][0], dp[2 * ks][1]); pw.y = pk2(dp[2 * ks][2], dp[2 * ks][3]); pw.z = pk2(dp[2 * ks + 1][0], dp[2 * ks + 1][1]); pw.w = pk2(dp[2 * ks + 1][2], dp[2 * ks + 1][3]);
            yp[ks] = __builtin_bit_cast(bf16x8, pw); }
#pragma unroll
        for (int dt = 0; dt < 4; ++dt) {
            dO[dt] = (f32x4){0.f, 0.f, 0.f, 0.f};
            const LAS unsigned char* vrow = L + OFF_VT + (64 * dvh + 16 * dt + fr) * LDW;
            const LAS unsigned char* srow = L + OFF_ST + (64 * dvh + 16 * dt + fr) * LDW;
#pragma unroll
            for (int ks = 0; ks < 2; ++ks) {
                const s16x4 lo = *(const LAS s16x4*)(vrow + (32 * ks + 4 * fq) * 2), hi = *(const LAS s16x4*)(vrow + (32 * ks + 16 + 4 * fq) * 2);
                const bf16x8 xv = (bf16x8){lo[0], lo[1], lo[2], lo[3], hi[0], hi[1], hi[2], hi[3]};
                dO[dt] = __builtin_amdgcn_mfma_f32_16x16x32_bf16(xv, yp[ks], dO[dt], 0, 0, 0);
                const bf16x8 xs = *(const LAS bf16x8*)(srow + (32 * ks + 8 * fq) * 2);
                const bf16x8 y2 = *(const LAS bf16x8*)(L + OFF_Q2 + (16 * it + fr) * LDW + (32 * ks + 8 * fq) * 2);
                dO[dt] = __builtin_amdgcn_mfma_f32_16x16x32_bf16(xs, y2, dO[dt], 0, 0, 0);
            }
        }
    }
    {
        f32x4 dU[4];
#pragma unroll
        for (int nt = 0; nt < 4; ++nt) dU[nt] = (f32x4){0.f, 0.f, 0.f, 0.f};
#pragma unroll
        for (int ks = 0; ks < 2; ++ks) {
            const bf16x8 yv = *(const LAS bf16x8*)(L + OFF_VT + (16 * w + fr) * LDW + (32 * ks + 8 * fq) * 2);
#pragma unroll
            for (int nt = 0; nt < 4; ++nt) { const bf16x8 xk = *(const LAS bf16x8*)(L + OFF_K2T + (16 * nt + fr) * LDW + (32 * ks + 8 * fq) * 2);
                dU[nt] = __builtin_amdgcn_mfma_f32_16x16x32_bf16(xk, yv, dU[nt], 0, 0, 0); }
        }
#pragma unroll
        for (int nt = 0; nt < 4; ++nt) { const f32x4 dc = *(const LAS f32x4*)(L + OFF_DEC + (16 * nt + 4 * fq) * 4); S[nt] = dc * S[nt] + dU[nt]; }
    }
    if (FULL) {
        float ss = 0.f;
#pragma unroll
        for (int dt = 0; dt < 4; ++dt) ss += (dO[dt][0] * dO[dt][0] + dO[dt][1] * dO[dt][1]) + (dO[dt][2] * dO[dt][2] + dO[dt][3] * dO[dt][3]);
        ss += __shfl_xor(ss, 16); ss += __shfl_xor(ss, 32);
        LAS float* SS = (LAS float*)(L + OFF_SS);
        if (fq == 0) SS[dvh * 64 + 16 * it + fr] = ss;
        LDS_WAIT(); __syncthreads();
        const float r = rsqrtf((SS[16 * it + fr] + SS[64 + 16 * it + fr]) * (1.f / 128.f) + EPS);
        const size_t row = row0 + 16 * it + fr;
#pragma unroll
        for (int dt = 0; dt < 4; ++dt) { const int dv0 = 64 * dvh + 16 * dt + 4 * fq;
            const f32x4 g4 = *(const f32x4*)(C.g_out + dv0); const f32x4 sg = ld4(C.SGR + row * 512 + h * 128 + dv0);
            const f32x4 o = dO[dt] * r * g4 * sg;
            u32x2 ow; ow.x = pk2(o[0], o[1]); ow.y = pk2(o[2], o[3]);
            *(u32x2*)(C.OMIX + row * 1024 + h * 128 + dv0) = ow; }
    }
    LDS_WAIT(); __syncthreads();
}

template <bool FULL>
__device__ __forceinline__ void phase(Frame& F, const Ctx& C) {
    const int lane = F.lane, w = F.wave, fr = lane & 15, fq = lane >> 4;
    for (int unit = F.vcu; unit < 256; unit += F.G) {
        const int bh = unit >> 5, seg = unit & 31, b = bh >> 2, h = bh & 3;
        f32x4 S[4];
#pragma unroll
        for (int nt = 0; nt < 4; ++nt) S[nt] = (f32x4){0.f, 0.f, 0.f, 0.f};
        float sumtot = 0.f;
        if (FULL) {
            for (int q = 0; q < seg; ++q) { const int uq = bh * 32 + q;
#pragma unroll
                for (int nt = 0; nt < 4; ++nt) { const f32x4 dq = *(const f32x4*)(C.GDEC + uq * 64 + 16 * nt + 4 * fq);
                    const f32x4 uu = *(const f32x4*)(C.GST + (size_t)uq * 8192 + (16 * w + fr) * 64 + 16 * nt + 4 * fq);
                    S[nt] = dq * S[nt] + uu; } }
        }
        for (int c = 0; c < 4; ++c) chunk<FULL>(F, C, b, h, (size_t)b * SEQ + seg * 256 + c * 64, S, sumtot);
        if (!FULL) {
#pragma unroll
            for (int nt = 0; nt < 4; ++nt) *(f32x4*)(C.GST + (size_t)unit * 8192 + (16 * w + fr) * 64 + 16 * nt + 4 * fq) = S[nt];
            if (w == 0) C.GDEC[unit * 64 + (F.tid & 63)] = __expf(sumtot);
        }
    }
}
}
namespace swa {
typedef short bf16x8 __attribute__((ext_vector_type(8)));
typedef short s16x4 __attribute__((ext_vector_type(4)));
typedef unsigned u32x2 __attribute__((ext_vector_type(2)));
constexpr int KLD = 144, VLD = 528, OFF_K = 0, OFF_VT = 256 * KLD, LDS_END = OFF_VT + 64 * VLD;
static_assert(LDS_END <= RING_BYTES, "swa LDS");

__device__ __forceinline__ void phase(Frame& F, const bf16* SQ, const bf16* SK, const bf16* SV, const float* sinks, bf16* OMIX) {
    LAS unsigned char* L = F.lds + RING_OFF;
    const int tid = F.tid, lane = F.lane, w = F.wave, fr = lane & 15, fq = lane >> 4;
    for (int unit = F.vcu; unit < 256; unit += F.G) {
        const int qb = unit & 63, kvh = (unit >> 6) & 1, b = unit >> 7;
        const int t0 = qb * 128, kstart = t0 - 128;
#pragma unroll
        for (int j = 0; j < 4; ++j) {
            const int p = tid + 512 * j, key = p >> 3, ch = p & 7, tok = kstart + key;
            v4u kv = (v4u){0u, 0u, 0u, 0u}, vv = (v4u){0u, 0u, 0u, 0u};
            if (tok >= 0) { const size_t off = ((size_t)b * SEQ + tok) * 128 + kvh * 64 + ch * 8; kv = *(const v4u*)(SK + off); vv = *(const v4u*)(SV + off); }
            *(LAS v4u*)(L + OFF_K + key * KLD + ch * 16) = kv;
            const unsigned vw[4] = {vv.x, vv.y, vv.z, vv.w};
#pragma unroll
            for (int e = 0; e < 8; ++e) *(LAS unsigned short*)(L + OFF_VT + (ch * 8 + e) * VLD + key * 2) = (unsigned short)(vw[e >> 1] >> ((e & 1) * 16));
        }
        LDS_WAIT(); __syncthreads();
        const int hq = 4 * kvh + (w >> 1);
        const float sink2 = sinks[hq] * LOG2E;
        for (int qt = 0; qt < 4; ++qt) {
            const int i0 = (w & 1) * 64 + 16 * qt, T0 = i0 >> 4, i = i0 + fr;
            const size_t qrow = (size_t)b * SEQ + t0 + i;
            bf16x8 yq[2];
#pragma unroll
            for (int ks = 0; ks < 2; ++ks) yq[ks] = *(const bf16x8*)(SQ + qrow * 512 + hq * 64 + 32 * ks + 8 * fq);
            f32x4 ds[10];
#pragma unroll
            for (int nt = 0; nt < 10; ++nt) {
                ds[nt] = (f32x4){0.f, 0.f, 0.f, 0.f};
                const int kt = min(T0 + nt, 15);
#pragma unroll
                for (int ks = 0; ks < 2; ++ks) { const bf16x8 xk = *(const LAS bf16x8*)(L + OFF_K + (16 * kt + fr) * KLD + (32 * ks + 8 * fq) * 2);
                    ds[nt] = __builtin_amdgcn_mfma_f32_16x16x32_bf16(xk, yq[ks], ds[nt], 0, 0, 0); }
            }
            float mx = sink2;
#pragma unroll
            for (int nt = 0; nt < 10; ++nt)
#pragma unroll
                for (int r = 0; r < 4; ++r) { const int kj = 16 * (T0 + nt) + 4 * fq + r;
                    const bool valid = (kj >= i + 1) && (kj <= i + 128) && (kstart + kj >= 0);
                    ds[nt][r] = valid ? ds[nt][r] : -INFINITY; mx = fmaxf(mx, ds[nt][r]); }
            mx = fmaxf(mx, __shfl_xor(mx, 16)); mx = fmaxf(mx, __shfl_xor(mx, 32));
            float l = 0.f;
#pragma unroll
            for (int nt = 0; nt < 10; ++nt)
#pragma unroll
                for (int r = 0; r < 4; ++r) { const float p = exp2f(ds[nt][r] - mx); ds[nt][r] = p; l += p; }
            l += __shfl_xor(l, 16); l += __shfl_xor(l, 32);
            l += exp2f(sink2 - mx);
            const float il = 1.f / l;
            bf16x8 yp[5];
#pragma unroll
            for (int ks = 0; ks < 5; ++ks) { v4u pw; pw.x = pk2(ds[2 * ks][0], ds[2 * ks][1]); pw.y = pk2(ds[2 * ks][2], ds[2 * ks][3]); pw.z = pk2(ds[2 * ks + 1][0], ds[2 * ks + 1][1]); pw.w = pk2(ds[2 * ks + 1][2], ds[2 * ks + 1][3]);
                yp[ks] = __builtin_bit_cast(bf16x8, pw); }
#pragma unroll
            for (int dt = 0; dt < 4; ++dt) {
                f32x4 o = (f32x4){0.f, 0.f, 0.f, 0.f};
                const LAS unsigned char* vrow = L + OFF_VT + (16 * dt + fr) * VLD;
#pragma unroll
                for (int ks = 0; ks < 5; ++ks) {
                    const int ka = min(T0 + 2 * ks, 15), kb = min(T0 + 2 * ks + 1, 15);
                    const s16x4 lo = *(const LAS s16x4*)(vrow + (16 * ka + 4 * fq) * 2), hi = *(const LAS s16x4*)(vrow + (16 * kb + 4 * fq) * 2);
                    const bf16x8 xv = (bf16x8){lo[0], lo[1], lo[2], lo[3], hi[0], hi[1], hi[2], hi[3]};
                    o = __builtin_amdgcn_mfma_f32_16x16x32_bf16(xv, yp[ks], o, 0, 0, 0);
                }
                o = o * il;
                u32x2 ow; ow.x = pk2(o[0], o[1]); ow.y = pk2(o[2], o[3]);
                *(u32x2*)(OMIX + qrow * 1024 + 512 + hq * 64 + 16 * dt + 4 * fq) = ow;
            }
        }
        LDS_WAIT(); __syncthreads();
    }
}
}
struct Args { const void* in[22]; float* out; unsigned char* ws; int ph_lo, ph_hi, li, pad; };
enum { PH_PREP = 0, PH_XN = 1, PH_INPROJ = 2, PH_MIX = 3, PH_MIX2 = 4, PH_OUTPROJ = 5, PH_NORM2 = 6, PH_FFN1 = 7, PH_ROUTE = 8, PH_MOE = 9, PH_FINAL = 10, PH_END = 11 };

__global__ void __launch_bounds__(NTHREADS, 2) mega_fwd(Args args) {
    extern __shared__ __attribute__((aligned(16))) unsigned char lds[];
    Frame F;
    F.lds = (LAS unsigned char*)lds;
    F.MISC = (volatile LAS unsigned*)(F.lds + MISC_OFF);
    F.tid = threadIdx.x; F.lane = F.tid & 63; F.wave = __builtin_amdgcn_readfirstlane(F.tid >> 6);
    F.G = gridDim.x; { const int bx = blockIdx.x; F.vcu = (F.G % 8 == 0) ? (bx % 8) * (F.G / 8) + bx / 8 : bx; }
    F.ws = args.ws; F.ctl = (gu32*)(args.ws + WS_CTL);
    for (int u = F.tid; u < (LDS_BYTES - LDSCTL_OFF) / 4; u += NTHREADS) ((LAS unsigned*)(F.lds + LDSCTL_OFF))[u] = 0u;
    __syncthreads();
    XcdBarrier bar = xcd_barrier_post((unsigned*)(F.ctl + CW_BAR) + args.li * XCD_BAR_WORDS, F.MISC + 8);
    const int lo = args.ph_lo, hi = args.ph_hi;
#define IN(k) (lo <= (k) && (k) < hi)
#define BOTH(k) (IN(k) && IN((k) + 1))
#define SEAM(k) do { if (BOTH(k)) xcd_barrier(bar); } while (0)
    const float* x = (const float*)args.in[0];
    unsigned char* ws = F.ws;
    int* cnt = (int*)(ws + WS_CTL) + CW_CNT; int* list = (int*)(ws + WS_LIST); float* wts = (float*)(ws + WS_WTS);

    if (IN(PH_PREP)) {
        P0In I{(const float*)args.in[1], (const float*)args.in[3], (const float*)args.in[4], (const float*)args.in[6], (const float*)args.in[7], (const float*)args.in[11],
               (const float*)args.in[13], (const float*)args.in[18], (const float*)args.in[19], (const float*)args.in[20], (const int*)args.in[2]};
        p0a_prep(F, I);
        SEAM(PH_PREP);
    }
    if (IN(PH_XN)) {
        norm_rows(F, x, (const float*)args.in[5], 0, 1024, (bf16*)(ws + WS_XN));
        SEAM(PH_XN);
    }
    if (IN(PH_INPROJ)) {
        pg8::Gemm g{(const pg8::bf16_t*)(ws + WS_XN), (const pg8::bf16_t*)(ws + WS_W1T), M, N1, D};
        pg8::StaticOrder S; S.init(M, N1, F.G, (int)blockIdx.x);
        EpiP1 E{ws, (const float*)args.in[8]};
        pg8::gemm_phase<EpiP1, pg8::StaticOrder, true, true>(F.lds + RING_OFF, g, S, E);
        SEAM(PH_INPROJ);
    }
    const gla::Ctx GC{(const bf16*)(ws + WS_GQ), (const bf16*)(ws + WS_GK), (const bf16*)(ws + WS_GV), (const bf16*)(ws + WS_SGR), (const float*)(ws + WS_LA), (const float*)args.in[9],
                      (float*)(ws + WS_GST), (float*)(ws + WS_GST + 8 * MiB), (bf16*)(ws + WS_OMIX)};
    if (IN(PH_MIX)) {
        gla::phase<false>(F, GC);
        swa::phase(F, (const bf16*)(ws + WS_SQ), (const bf16*)(ws + WS_SK), (const bf16*)(ws + WS_SV), (const float*)args.in[10], (bf16*)(ws + WS_OMIX));
        SEAM(PH_MIX);
    }
    if (IN(PH_MIX2)) {
        gla::phase<true>(F, GC);
        SEAM(PH_MIX2);
    }
    if (IN(PH_OUTPROJ)) {
        pg8::Gemm g{(const pg8::bf16_t*)(ws + WS_OMIX), (const pg8::bf16_t*)(ws + WS_WOT), M, D, D};
        pg8::StaticOrder S; S.init(M, D, F.G, (int)blockIdx.x);
        EpiXmid E{x, (const float*)(ws + WS_MOD), (float*)(ws + WS_XMID)};
        pg8::gemm_phase<EpiXmid, pg8::StaticOrder, true, true>(F.lds + RING_OFF, g, S, E);
        SEAM(PH_OUTPROJ);
    }
    if (IN(PH_NORM2)) {
        norm_rows(F, (const float*)(ws + WS_XMID), (const float*)args.in[12], 3072, 4096, (bf16*)(ws + WS_H2));
        SEAM(PH_NORM2);
    }
    if (IN(PH_FFN1)) {
        pg8::Gemm g{(const pg8::bf16_t*)(ws + WS_H2), (const pg8::bf16_t*)(ws + WS_W4T), M, 768, D};
        pg8::StaticOrder S; S.init(M, 768, F.G, (int)blockIdx.x);
        EpiP4 E{(float*)(ws + WS_LOGITS), (bf16*)(ws + WS_SACT)};
        pg8::gemm_phase<EpiP4, pg8::StaticOrder, true, true>(F.lds + RING_OFF, g, S, E);
        SEAM(PH_FFN1);
    }
    if (IN(PH_ROUTE)) {
        route_tokens(F, (const float*)(ws + WS_LOGITS), (const float*)args.in[14], cnt, list, wts);
        pg8::Gemm g{(const pg8::bf16_t*)(ws + WS_SACT), (const pg8::bf16_t*)(ws + WS_WSDT), M, D, 256};
        pg8::StaticOrder S; S.init(M, D, F.G, (int)blockIdx.x);
        EpiF32x E{(float*)(ws + WS_SHOUT), D};
        pg8::gemm_phase<EpiF32x, pg8::StaticOrder, true, true>(F.lds + RING_OFF, g, S, E);
        SEAM(PH_ROUTE);
    }
    if (IN(PH_MOE)) {
        moe::Ctx C{(const bf16*)(ws + WS_H2), (const float*)args.in[15], (const float*)args.in[16], (const float*)args.in[17], list, wts, (bf16*)(ws + WS_ACT), (bf16*)(ws + WS_SLOTS)};
        moe::phase(F, C, cnt);
        SEAM(PH_MOE);
    }
    if (IN(PH_FINAL)) {
        final_rows_slots(F, (const float*)(ws + WS_XMID), (const float*)(ws + WS_SHOUT), (const bf16*)(ws + WS_SLOTS), (const float*)args.in[21], args.out);
    }
#undef IN
#undef BOTH
#undef SEAM
}
extern "C" void kernel_launch(void* const* d_in, const int* in_sizes, int n_in, void* d_out, int out_size, void* d_ws, size_t ws_size, hipStream_t stream) {
    static int grid = 0;
    if (grid == 0) {
        if (n_in != 22 || out_size != M * D || ws_size < (size_t)1000 * MiB) { fprintf(stderr, "kernel_launch: unexpected shapes (n_in %d, out %d, ws %zu)\n", n_in, out_size, ws_size); grid = -1; return; }
        int dev = 0, cus = 0, per_cu = 0;
        if (hipGetDevice(&dev) != hipSuccess || hipDeviceGetAttribute(&cus, hipDeviceAttributeMultiprocessorCount, dev) != hipSuccess) { grid = -1; return; }
        if (hipFuncSetAttribute((const void*)mega_fwd, hipFuncAttributeMaxDynamicSharedMemorySize, LDS_BYTES) != hipSuccess) { fprintf(stderr, "kernel_launch: hipFuncSetAttribute failed\n"); grid = -1; return; }
        if (hipOccupancyMaxActiveBlocksPerMultiprocessor(&per_cu, (const void*)mega_fwd, NTHREADS, LDS_BYTES) != hipSuccess || per_cu < 1) fprintf(stderr, "kernel_launch: occupancy query reports %d\n", per_cu);
        (void)hipGetLastError();
        grid = cus;
    }
    if (grid < 0) return;
    unsigned char* ws = (unsigned char*)d_ws;
    (void)hipMemsetAsync(ws + WS_CTL, 0, CTL_ZERO_BYTES, stream);
    Args a{};
    for (int i = 0; i < 22; ++i) a.in[i] = d_in[i];
    a.out = (float*)d_out; a.ws = ws;
    a.ph_lo = 0; a.ph_hi = PH_END; a.li = 0;
    hipLaunchKernelGGL(mega_fwd, dim3(grid), dim3(NTHREADS), LDS_BYTES, stream, a);
}
```

```cpp
#include <hip/hip_runtime.h>
#include <cstdio>
#include <cstdint>
#include <math.h>
namespace pg8 {
#define PG8_LAS __attribute__((address_space(3)))
typedef unsigned short bf16_t;
typedef short bf16x8 __attribute__((ext_vector_type(8)));
typedef float f32x4 __attribute__((ext_vector_type(4)));
typedef unsigned u32x4 __attribute__((ext_vector_type(4)));
constexpr int BM = 256, BK = 64, HALF = 128, HTB = HALF * BK * 2  , STAGE_BYTES = 8 * HTB, NXCD = 8, WGM = 8;

__host__ __device__ __forceinline__ int lds_byte(int r, int c) { const int st = (r >> 4) * 2 + (c >> 5), rr = r & 15, cc = c & 31, ob = rr * 64 + cc * 2; return st * 1024 + (ob ^ (((ob >> 9) & 1) << 5)); }
__host__ __device__ __forceinline__ void stage_rc(int b, int& R, int& C) { const int st = b / 1024, sb = b % 1024, swz = sb ^ (((sb >> 9) & 1) << 5); R = (st >> 1) * 16 + swz / 64; C = (st & 1) * 32 + (swz % 64) / 2; }
__host__ __device__ __forceinline__ int perm32(int rho) { const int n = rho >> 4, i = rho & 15; return 8 * (i >> 2) + 4 * n + (i & 3); }

struct Unit { int pm, pn; };
struct Gemm { const bf16_t* A; const bf16_t* Bt; int M, N, K; };

struct StaticOrder {
    int nM, nN, nwg, G, c;
    __host__ __device__ void init(int M, int N, int G_, int c_) { nM = M / BM; nN = N / BM; nwg = nM * nN; G = G_; c = c_; }
    __host__ __device__ bool next(int i, Unit& u) const {
        const long L = (long)i * G + c; if (L >= nwg) return false;
        int wgid = (int)L; { const int q = nwg / NXCD, r = nwg % NXCD, xcd = wgid % NXCD, off = wgid / NXCD; wgid = (xcd < r ? xcd * (q + 1) : r * (q + 1) + (xcd - r) * q) + off; }
        const int nig = WGM * nN, gid = wgid / nig, fm = gid * WGM, gsz = (nM - fm) < WGM ? (nM - fm) : WGM;
        u.pm = fm + ((wgid % nig) % gsz); u.pn = (wgid % nig) / gsz; return true;
    }
    __device__ __forceinline__ void a_ready(const Unit&) const {}
    __device__ __forceinline__ void done(const Unit&) const {}
};

__device__ __forceinline__ unsigned cvt_pk_bf16(float lo, float hi) { unsigned r; asm volatile("v_cvt_pk_bf16_f32 %0, %1, %2" : "=v"(r) : "v"(lo), "v"(hi)); return r; }
typedef float f32x2 __attribute__((ext_vector_type(2)));
__device__ __forceinline__ f32x2 gelu_pk(f32x2 v) {
    const f32x2 av = __builtin_elementwise_abs(v), d = av * 0.2316418882f + 1.0f;
    f32x2 t; t.x = __builtin_amdgcn_rcpf(d.x); t.y = __builtin_amdgcn_rcpf(d.y);
    f32x2 q = t * 0.5307027145f + (-0.7265760135f); q = q * t + 0.7107068705f; q = q * t + (-0.142248368f); q = q * t + 0.127414796f; q = q * t;
    const f32x2 s = (v * v) * (-0.72134752044f);
    f32x2 e; e.x = __builtin_amdgcn_exp2f(s.x); e.y = __builtin_amdgcn_exp2f(s.y);
    const f32x2 m = v * (q * e), r = v - m;
    f32x2 o; o.x = v.x < 0.f ? m.x : r.x; o.y = v.y < 0.f ? m.y : r.y; return o;
}

template <int ACT  > struct EpiBf16 {
    static constexpr bool PERM = true, AFTER_DRAIN = false; static_assert(ACT == 0 || ACT == 1, "EpiBf16: ACT is 0 (none) or 1 (gelu_pk)");
    bf16_t* O; int ldc; const float* bias; int split_cols; size_t split_stride; float scale0;
    __device__ __forceinline__ void operator()(const f32x4 (&acc)[2][2][4][2], const Unit& u, int wr, int wc, int fr, int fq) const {
        const int row0 = u.pm * BM + wr * 64 + fr; int colt = u.pn * BM; bf16_t* base = O;
        float sc = 1.f; if (split_cols) { const int t = colt / split_cols; base += (size_t)t * split_stride; colt -= t * split_cols; if (t == 0) sc = scale0; }
        const int col0 = colt + wc * 32 + 8 * fq, bcol0 = u.pn * BM + wc * 32 + 8 * fq;
        f32x4 bv[2][2];
#pragma unroll
        for (int bj = 0; bj < 2; ++bj)
#pragma unroll
            for (int n = 0; n < 2; ++n) bv[bj][n] = bias ? *(const f32x4*)(bias + bcol0 + bj * HALF + 4 * n) : (f32x4){0.f, 0.f, 0.f, 0.f};
#pragma unroll
        for (int ai = 0; ai < 2; ++ai)
#pragma unroll
            for (int m = 0; m < 4; ++m) { bf16_t* rowp = base + (size_t)(row0 + ai * HALF + m * 16) * ldc + col0;
#pragma unroll
                for (int bj = 0; bj < 2; ++bj) { f32x4 v0 = acc[ai][bj][m][0] + bv[bj][0], v1 = acc[ai][bj][m][1] + bv[bj][1];
                    if (ACT == 1) { f32x2 a = gelu_pk((f32x2){v0[0], v0[1]}), b = gelu_pk((f32x2){v0[2], v0[3]}), c = gelu_pk((f32x2){v1[0], v1[1]}), d = gelu_pk((f32x2){v1[2], v1[3]});
                        v0 = (f32x4){a.x, a.y, b.x, b.y}; v1 = (f32x4){c.x, c.y, d.x, d.y}; }
                    v0 = v0 * sc; v1 = v1 * sc; u32x4 w; w.x = cvt_pk_bf16(v0[0], v0[1]); w.y = cvt_pk_bf16(v0[2], v0[3]); w.z = cvt_pk_bf16(v1[0], v1[1]); w.w = cvt_pk_bf16(v1[2], v1[3]);
                    *(u32x4*)(rowp + bj * HALF) = w; } }
    }
};

struct PanelStats {
    unsigned* xbuf;
    unsigned* cnt;
    unsigned* tmo;
    int ntn; float eps;
    unsigned code;
    __device__ __forceinline__ bool run(const f32x4 (&v)[2][2][4][2], const Unit& u, int wr, int wc, int fr, int fq, PG8_LAS unsigned char* lds, int wid, int lane) const {
        typedef float f32x2v __attribute__((ext_vector_type(2)));
        PG8_LAS f32x2v* P = (PG8_LAS f32x2v*)lds;
        PG8_LAS f32x2v* S = (PG8_LAS f32x2v*)(lds + 8192);
        PG8_LAS unsigned* flag = (PG8_LAS unsigned*)(lds + 8192 + 2048);
#pragma unroll
        for (int ai = 0; ai < 2; ++ai)
#pragma unroll
            for (int m = 0; m < 4; ++m) {
                float s = 0.f;
#pragma unroll
                for (int bj = 0; bj < 2; ++bj)
#pragma unroll
                    for (int n = 0; n < 2; ++n) { const f32x4 x = v[ai][bj][m][n]; s += (x[0] + x[1]) + (x[2] + x[3]); }
                s += __shfl_xor(s, 16); s += __shfl_xor(s, 32);
                const float mw = s * (1.0f / 64.0f); float q = 0.f;
#pragma unroll
                for (int bj = 0; bj < 2; ++bj)
#pragma unroll
                    for (int n = 0; n < 2; ++n) { const f32x4 d = v[ai][bj][m][n] - mw; q += (d[0] * d[0] + d[1] * d[1]) + (d[2] * d[2] + d[3] * d[3]); }
                q += __shfl_xor(q, 16); q += __shfl_xor(q, 32);
                if (fq == 0) P[(ai * HALF + wr * 64 + m * 16 + fr) * 4 + wc] = (f32x2v){mw, q};
            }
        asm volatile("s_waitcnt lgkmcnt(0)" ::: "memory"); __builtin_amdgcn_s_barrier(); asm volatile("" ::: "memory");
#if defined(BROKEN_EXCHANGE_NO_WAIT)
#warning BROKEN CONTROL BUILD: the row-statistics exchange does not wait; results are wrong by design
        if (blockIdx.x >= 64) { const long long t0_ = clock64(); while (clock64() - t0_ < 60000) __builtin_amdgcn_s_sleep(8); }
#endif
        const int row = wid * 32 + (lane & 31);
        if (lane < 32) {
            const f32x2v a = P[row * 4 + 0], b = P[row * 4 + 1], c = P[row * 4 + 2], d = P[row * 4 + 3];
            const float mt = (a.x + b.x + c.x + d.x) * 0.25f;
            const float da = a.x - mt, db = b.x - mt, dc = c.x - mt, dd = d.x - mt;
            const float m2 = (a.y + b.y) + (c.y + d.y) + 64.0f * ((da * da + db * db) + (dc * dc + dd * dd));
            unsigned long long* slot = (unsigned long long*)xbuf + ((size_t)(u.pm * BM + row) * 4 + u.pn);
            __hip_atomic_store(slot, ((unsigned long long)__float_as_uint(m2) << 32) | __float_as_uint(mt), __ATOMIC_RELAXED, __HIP_MEMORY_SCOPE_AGENT);
        }
        asm volatile("s_waitcnt vmcnt(0)" ::: "memory");
        if (lane == 0) __hip_atomic_fetch_add(cnt + 64 * u.pm, 1u, __ATOMIC_RELAXED, __HIP_MEMORY_SCOPE_AGENT);
        if (wid == 0) {
            bool dead = false; const unsigned long long t0 = __builtin_amdgcn_s_memrealtime(); const unsigned want = 8u * (unsigned)ntn;
            for (;;) {
#if defined(BROKEN_EXCHANGE_NO_WAIT)
                break;
#endif
                if ((unsigned)__builtin_amdgcn_readfirstlane(__hip_atomic_load(cnt + 64 * u.pm, __ATOMIC_RELAXED, __HIP_MEMORY_SCOPE_AGENT)) >= want) break;
                if (__builtin_amdgcn_s_memrealtime() - t0 > 2000000ull) {
                    if (lane == 0) { unsigned expect = 0u; __hip_atomic_compare_exchange_strong(tmo + 1, &expect, code | (unsigned)(u.pm & 0xff), __ATOMIC_RELAXED, __ATOMIC_RELAXED, __HIP_MEMORY_SCOPE_AGENT);
                                     __hip_atomic_store(tmo, 1u, __ATOMIC_RELAXED, __HIP_MEMORY_SCOPE_AGENT); }
                    dead = true; break; }
                __builtin_amdgcn_s_sleep(2);
            }
            __builtin_amdgcn_fence(__ATOMIC_ACQUIRE, "agent");
            if (lane == 0) flag[0] = dead ? 1u : 0u;
        }
        asm volatile("s_waitcnt vmcnt(0) lgkmcnt(0)" ::: "memory"); __builtin_amdgcn_s_barrier(); asm volatile("" ::: "memory");
        const bool bad = flag[0] != 0u;
        if (lane < 32) {
            const unsigned long long* slot = (const unsigned long long*)xbuf + (size_t)(u.pm * BM + row) * 4; float mt[4], m2[4]; float ms = 0.f;
#pragma unroll
            for (int t = 0; t < 4; ++t) { if (t < ntn) { const unsigned long long w = __hip_atomic_load(slot + t, __ATOMIC_RELAXED, __HIP_MEMORY_SCOPE_AGENT); mt[t] = __uint_as_float((unsigned)w); m2[t] = __uint_as_float((unsigned)(w >> 32)); } else { mt[t] = 0.f; m2[t] = 0.f; } ms += mt[t]; }
            const float mean = ms / (float)ntn; float q = 0.f;
#pragma unroll
            for (int t = 0; t < 4; ++t) if (t < ntn) { const float dm = mt[t] - mean; q += m2[t] + 256.0f * dm * dm; }
            S[row] = (f32x2v){mean, 1.0f / sqrtf(q / (256.0f * (float)ntn) + eps)};
        }
        asm volatile("s_waitcnt lgkmcnt(0)" ::: "memory"); __builtin_amdgcn_s_barrier(); asm volatile("" ::: "memory");
        return bad;
    }
};

template <class Epi, class Sched, bool ALIGN_EPI = false, bool SP2 = false>
__device__ __forceinline__ void gemm_phase(PG8_LAS unsigned char* lds, const Gemm g, const Sched& S, const Epi& E) {
    const int tid = threadIdx.x, wid = __builtin_amdgcn_readfirstlane(tid >> 6), lane = tid & 63, wr = wid >> 2, wc = wid & 3, fr = lane & 15, fq = lane >> 4;
    const int K = g.K, nt = K / BK;
    unsigned voffA[2], voffB[2];
#pragma unroll
    for (int i = 0; i < 2; ++i) { int R, C; stage_rc(tid * 16 + i * 8192, R, C); const int Rb = Epi::PERM ? ((R & ~31) + perm32(R & 31)) : R;
        voffA[i] = (unsigned)(R * K + C) * 2u; voffB[i] = (unsigned)(Rb * K + C) * 2u; }
    const size_t kstep = (size_t)(BK * 2);
    const size_t hstep = (size_t)HALF * K * 2;
    const size_t tstep = 2 * hstep;
    const unsigned ldsw = (unsigned)wid * 1024u;
    const int aoff = lds_byte(wr * 64 + fr, fq * 8), boff = lds_byte(wc * 32 + fr, fq * 8);
#define PG8_SA(b, h) (((b) * 2 + (h)) * HTB)
#define PG8_SB(b, h) ((4 + (b) * 2 + (h)) * HTB)
#define PG8_STAGE(bufoff, gbase, voff) do { _Pragma("unroll") for (int _i = 0; _i < 2; ++_i) \
        __builtin_amdgcn_global_load_lds((const unsigned*)((const char*)(gbase) + (voff)[_i]), (PG8_LAS unsigned*)(lds + (bufoff) + ldsw + _i * 8192), 16, 0, 0); } while (0)
#define PG8_LDA(dst, b, h) do { _Pragma("unroll") for (int m = 0; m < 4; ++m) _Pragma("unroll") for (int k = 0; k < 2; ++k) dst[m][k] = *(const PG8_LAS bf16x8*)(lds + PG8_SA(b, h) + aoff + m * 2048 + k * 1024); } while (0)
#define PG8_LDB(dst, b, h) do { _Pragma("unroll") for (int n = 0; n < 2; ++n) _Pragma("unroll") for (int k = 0; k < 2; ++k) dst[n][k] = *(const PG8_LAS bf16x8*)(lds + PG8_SB(b, h) + boff + n * 2048 + k * 1024); } while (0)
#define PG8_MMA(ai, bj, At, Bt) do { __builtin_amdgcn_s_setprio(1); _Pragma("unroll") for (int m = 0; m < 4; ++m) _Pragma("unroll") for (int n = 0; n < 2; ++n) _Pragma("unroll") for (int k = 0; k < 2; ++k) \
        acc[ai][bj][m][n] = __builtin_amdgcn_mfma_f32_16x16x32_bf16(Bt[n][k], At[m][k], acc[ai][bj][m][n], 0, 0, 0); __builtin_amdgcn_s_setprio(0); } while (0)
#define PG8_WAIT_V(n) asm volatile("s_waitcnt vmcnt(" #n ")" ::: "memory")
#define PG8_WAIT_L(n) asm volatile("s_waitcnt lgkmcnt(" #n ")" ::: "memory")
#define PG8_BAR __builtin_amdgcn_s_barrier()
#define PG8_SCHED __builtin_amdgcn_sched_barrier(0)
    Unit cur, nxt; int ui = 0;
    if (!S.next(0, cur)) return;
    f32x4 acc[2][2][4][2];
#pragma unroll
    for (int a = 0; a < 2; ++a)
#pragma unroll
        for (int b = 0; b < 2; ++b)
#pragma unroll
            for (int m = 0; m < 4; ++m)
#pragma unroll
                for (int n = 0; n < 2; ++n) acc[a][b][m][n] = (f32x4){0.f, 0.f, 0.f, 0.f};
    bf16x8 At[4][2], B0[2][2], B1[2][2];
    const char* cA = (const char*)g.A + (size_t)cur.pm * tstep; const char* cB = (const char*)g.Bt + (size_t)cur.pn * tstep;
    S.a_ready(cur);
    if constexpr (SP2) {
        PG8_STAGE(PG8_SB(0, 0), cB, voffB); PG8_STAGE(PG8_SB(0, 1), cB + hstep, voffB); PG8_STAGE(PG8_SA(0, 0), cA, voffA); PG8_STAGE(PG8_SA(0, 1), cA + hstep, voffA);
        if (wr == 1) PG8_BAR;
        PG8_WAIT_V(2); PG8_BAR;
        PG8_STAGE(PG8_SB(1, 0), cB + kstep, voffB); PG8_STAGE(PG8_SA(1, 0), cA + kstep, voffA); PG8_STAGE(PG8_SB(1, 1), cB + hstep + kstep, voffB);
        PG8_WAIT_V(6); PG8_BAR;
    } else {
        PG8_STAGE(PG8_SB(0, 0), cB, voffB); PG8_STAGE(PG8_SA(0, 0), cA, voffA); PG8_STAGE(PG8_SB(0, 1), cB + hstep, voffB); PG8_STAGE(PG8_SA(0, 1), cA + hstep, voffA);
        if (wr == 1) PG8_BAR;
        PG8_WAIT_V(4); PG8_BAR;
        PG8_STAGE(PG8_SB(1, 0), cB + kstep, voffB); PG8_STAGE(PG8_SA(1, 0), cA + kstep, voffA); PG8_STAGE(PG8_SB(1, 1), cB + hstep + kstep, voffB);
        PG8_WAIT_V(6); PG8_BAR;
    }
    for (;;) {
        const bool has_next = S.next(ui + 1, nxt);
        const char* nA = has_next ? (const char*)g.A + (size_t)nxt.pm * tstep : cA; const char* nB = has_next ? (const char*)g.Bt + (size_t)nxt.pn * tstep : cB;
        for (int t = 0; t < nt; t += 2) {
            const bool last = (t == nt - 2);
            const char* a1 = cA + (size_t)(t + 1) * kstep;
            const char* a2 = last ? nA : cA + (size_t)(t + 2) * kstep; const char* b2 = last ? nB : cB + (size_t)(t + 2) * kstep;
            const char* a3 = a2 + kstep; const char* b3 = b2 + kstep;
            if (last && has_next) S.a_ready(nxt);
            if constexpr (SP2) {
            PG8_LDB(B0, 0, 0); PG8_LDB(B1, 0, 1); PG8_SCHED; PG8_LDA(At, 0, 0); PG8_STAGE(PG8_SA(1, 1), a1 + hstep, voffA);
            PG8_WAIT_V(8); PG8_WAIT_L(0); PG8_BAR; PG8_MMA(0, 0, At, B0); PG8_MMA(0, 1, At, B1); PG8_BAR; PG8_SCHED;
            PG8_LDA(At, 0, 1); PG8_STAGE(PG8_SB(0, 0), b2, voffB); PG8_STAGE(PG8_SB(0, 1), b2 + hstep, voffB); PG8_STAGE(PG8_SA(0, 0), a2, voffA);
            PG8_WAIT_V(8); PG8_WAIT_L(0); PG8_BAR; PG8_MMA(1, 0, At, B0); PG8_MMA(1, 1, At, B1); PG8_BAR; PG8_SCHED;
            PG8_LDB(B0, 1, 0); PG8_LDB(B1, 1, 1); PG8_SCHED; PG8_LDA(At, 1, 0); PG8_STAGE(PG8_SA(0, 1), a2 + hstep, voffA);
            PG8_WAIT_V(8); PG8_WAIT_L(0); PG8_BAR; PG8_MMA(0, 0, At, B0); PG8_MMA(0, 1, At, B1); PG8_BAR; PG8_SCHED;
            PG8_LDA(At, 1, 1); PG8_STAGE(PG8_SB(1, 0), b3, voffB); PG8_STAGE(PG8_SB(1, 1), b3 + hstep, voffB); PG8_STAGE(PG8_SA(1, 0), a3, voffA);
            PG8_WAIT_V(8); PG8_WAIT_L(0); PG8_BAR; PG8_MMA(1, 0, At, B0); PG8_MMA(1, 1, At, B1); PG8_BAR; PG8_SCHED;
            } else {
            PG8_LDB(B0, 0, 0); PG8_SCHED; PG8_LDA(At, 0, 0); PG8_STAGE(PG8_SA(1, 1), a1 + hstep, voffA);
            PG8_WAIT_L(8); PG8_BAR; PG8_WAIT_L(0); PG8_MMA(0, 0, At, B0); PG8_BAR; PG8_SCHED;
            PG8_LDB(B1, 0, 1); PG8_STAGE(PG8_SB(0, 0), b2, voffB);
            PG8_BAR; PG8_WAIT_L(0); PG8_MMA(0, 1, At, B1); PG8_BAR;
            PG8_LDA(At, 0, 1); PG8_STAGE(PG8_SA(0, 0), a2, voffA);
            PG8_BAR; PG8_WAIT_L(0); PG8_MMA(1, 0, At, B0); PG8_BAR; PG8_SCHED;
            PG8_STAGE(PG8_SB(0, 1), b2 + hstep, voffB);
            PG8_WAIT_V(6); PG8_BAR; PG8_MMA(1, 1, At, B1); PG8_BAR;
            PG8_LDB(B0, 1, 0); PG8_SCHED; PG8_LDA(At, 1, 0); PG8_STAGE(PG8_SA(0, 1), a2 + hstep, voffA);
            PG8_WAIT_L(8); PG8_BAR; PG8_WAIT_L(0); PG8_MMA(0, 0, At, B0); PG8_BAR; PG8_SCHED;
            PG8_LDB(B1, 1, 1); PG8_STAGE(PG8_SB(1, 0), b3, voffB);
            PG8_BAR; PG8_WAIT_L(0); PG8_MMA(0, 1, At, B1); PG8_BAR;
            PG8_LDA(At, 1, 1); PG8_STAGE(PG8_SA(1, 0), a3, voffA);
            PG8_BAR; PG8_WAIT_L(0); PG8_MMA(1, 0, At, B0); PG8_BAR; PG8_SCHED;
            PG8_STAGE(PG8_SB(1, 1), b3 + hstep, voffB);
            PG8_WAIT_V(6); PG8_BAR; PG8_MMA(1, 1, At, B1); PG8_BAR;
            }
        }
        if constexpr (ALIGN_EPI) { if (wr == 0) PG8_BAR; }
        if constexpr (!Epi::AFTER_DRAIN) { E(acc, cur, wr, wc, fr, fq); S.done(cur); }
        if (!has_next) break;
#pragma unroll
        for (int a = 0; a < 2; ++a)
#pragma unroll
            for (int b = 0; b < 2; ++b)
#pragma unroll
                for (int m = 0; m < 4; ++m)
#pragma unroll
                    for (int n = 0; n < 2; ++n) acc[a][b][m][n] = (f32x4){0.f, 0.f, 0.f, 0.f};
        cur = nxt; cA = nA; cB = nB; ++ui;
        if constexpr (ALIGN_EPI) { if (wr == 1) PG8_BAR; }
    }
    PG8_WAIT_V(0);
    if constexpr (!ALIGN_EPI) { if (wr == 0) PG8_BAR; }
    PG8_BAR;
    if constexpr (Epi::AFTER_DRAIN) { E.fused(acc, cur, wr, wc, fr, fq, lds, wid, lane); S.done(cur); }
#undef PG8_SA
#undef PG8_SB
#undef PG8_STAGE
#undef PG8_LDA
#undef PG8_LDB
#undef PG8_MMA
#undef PG8_WAIT_V
#undef PG8_WAIT_L
#undef PG8_BAR
#undef PG8_SCHED
}
}
#define GAS __attribute__((address_space(1)))
#define LAS __attribute__((address_space(3)))
typedef unsigned short bf16;
typedef unsigned v4u __attribute__((ext_vector_type(4)));
typedef float f32x4 __attribute__((ext_vector_type(4)));
typedef short bf16x8 __attribute__((ext_vector_type(8)));
typedef GAS unsigned gu32;
typedef GAS unsigned long long gu64;
#define RLX_AGENT __ATOMIC_RELAXED, __HIP_MEMORY_SCOPE_AGENT
#define LDS_WAIT() asm volatile("s_waitcnt lgkmcnt(0)" ::: "memory")
#define VM_WAIT() asm volatile("s_waitcnt vmcnt(0)" ::: "memory")
__device__ __forceinline__ unsigned long long rt() { return __builtin_amdgcn_s_memrealtime(); }
__device__ __forceinline__ unsigned f2bf(float f) { unsigned u = __builtin_bit_cast(unsigned, f); return (u + 0x7fffu + ((u >> 16) & 1u)) >> 16; }
__device__ __forceinline__ unsigned pk2(float lo, float hi) { return f2bf(lo) | (f2bf(hi) << 16); }

#define XB_TMO      128
#define XB_XCNT(j)  (256  + 64 * (j))
#define XB_XSUB(j)  (1280 + 64 * (j))
#define XB_XGEN(j)  (2304 + 64 * (j))
#define XB_TOP      3328
#define XB_TOPGEN   3392
#define XCD_BAR_WORDS 3456
#define XB_SPIN_CAP (1u << 18)

__device__ __forceinline__ unsigned xb_ld(unsigned* p)              { return __hip_atomic_load(p, __ATOMIC_RELAXED, __HIP_MEMORY_SCOPE_AGENT); }
__device__ __forceinline__ unsigned xb_add(unsigned* p, unsigned v) { return __hip_atomic_fetch_add(p, v, __ATOMIC_RELAXED, __HIP_MEMORY_SCOPE_AGENT); }
__device__ __forceinline__ unsigned xb_xcc_id() { return (unsigned)__builtin_amdgcn_s_getreg((3 << 11) | 20) & 0xFu; }
#define XB_SPIN(cond, bar) do { unsigned _sp = 0; while (cond) { __builtin_amdgcn_s_sleep(1); \
    if ((++_sp & 255u) == 0u) { if (xb_ld(&(bar)[XB_TMO])) break; if (_sp > XB_SPIN_CAP) { atomicAdd(&(bar)[XB_TMO], 1u); break; } } } } while (0)

struct XcdBarrier {
    unsigned* bar; unsigned x;
    volatile LAS unsigned* st;
};

__device__ __forceinline__ XcdBarrier xcd_barrier_post(unsigned* bar, volatile LAS unsigned* st) {
    XcdBarrier b; b.bar = bar; b.x = xb_xcc_id(); b.st = st;
    if (threadIdx.x == 0) { const unsigned tk = xb_add(&bar[XB_XCNT(b.x)], 1u); st[2] = tk; st[3] = b.x; }
    return b;
}
__device__ __forceinline__ void xcd_barrier_complete(unsigned* bar, unsigned x, unsigned& nloc, unsigned& nx) {
    const unsigned G = gridDim.x * gridDim.y * gridDim.z;
    unsigned sum, cnt, mine, sp = 0u;
    for (;;) {
        sum = 0u; cnt = 0u; mine = 0u;
#pragma unroll
        for (unsigned j = 0; j < 16; ++j) { const unsigned c = xb_ld(&bar[XB_XCNT(j)]); sum += c; cnt += (c > 0u) ? 1u : 0u; mine = (j == x) ? c : mine; }
        if (sum == G) break;
        __builtin_amdgcn_s_sleep(1);
        if ((++sp & 255u) == 0u) { if (xb_ld(&bar[XB_TMO])) break; if (sp > XB_SPIN_CAP) { atomicAdd(&bar[XB_TMO], 1u); break; } }
    }
    nloc = mine > 0u ? mine : 1u; nx = cnt > 0u ? cnt : 1u;
}

__device__ __forceinline__ void xcd_barrier(const XcdBarrier& b) {
    asm volatile("s_waitcnt vmcnt(0)" ::: "memory");
    __syncthreads();
    if (threadIdx.x == 0) {
        unsigned* bar = b.bar;
        __builtin_amdgcn_s_waitcnt(0);
        unsigned nloc = b.st[0], nx = b.st[1];
        if (nloc == 0u) { xcd_barrier_complete(bar, b.x, nloc, nx); b.st[0] = nloc; b.st[1] = nx; }
        const unsigned old = xb_add(&bar[XB_XSUB(b.x)], 1u);
        const unsigned gen = old / nloc;
        if (old + 1u == (gen + 1u) * nloc) {
            __builtin_amdgcn_fence(__ATOMIC_RELEASE, "agent");
            asm volatile("s_waitcnt vmcnt(0)" ::: "memory");
            const unsigned og = xb_add(&bar[XB_TOP], 1u);
            const unsigned tg = og / nx;
            if (og + 1u == (tg + 1u) * nx) xb_add(&bar[XB_TOPGEN], 1u);
            else XB_SPIN(xb_ld(&bar[XB_TOPGEN]) == tg, bar);
            __builtin_amdgcn_fence(__ATOMIC_ACQUIRE, "agent");
            xb_add(&bar[XB_XGEN(b.x)], 1u);
            asm volatile("s_waitcnt vmcnt(0)" ::: "memory");
        } else {
            XB_SPIN(xb_ld(&bar[XB_XGEN(b.x)]) == gen, bar);
            __builtin_amdgcn_fence(__ATOMIC_ACQUIRE, "agent");
            asm volatile("s_waitcnt vmcnt(0)" ::: "memory");
        }
    }
    __syncthreads();
}
constexpr int NWAVES = 8, NTHREADS = 512;
constexpr int M = 16384, D = 1024, SEQ = 8192, INW = 2320, N1 = 2560, NE = 256, CAP = 16384;
constexpr float EPS = 1e-6f, LOG2E = 1.4426950408889634f, QS = 0.125f * 1.4426950408889634f;
constexpr size_t MiB = 1u << 20;
constexpr size_t WS_CTL = 0, CTL_ZERO_BYTES = 1 * MiB;
constexpr size_t WS_MOD = 1 * MiB, WS_CS = 2 * MiB, WS_W1T = 4 * MiB, WS_WOT = 10 * MiB, WS_W4T = 12 * MiB, WS_WSDT = 14 * MiB;
constexpr size_t WS_XN = 16 * MiB, WS_GQ = 48 * MiB, WS_GK = 56 * MiB, WS_GV = 64 * MiB, WS_LA = 80 * MiB, WS_SGR = 96 * MiB, WS_SQ = 112 * MiB, WS_SK = 128 * MiB, WS_SV = 132 * MiB;
constexpr size_t WS_OMIX = 136 * MiB, WS_XMID = 168 * MiB, WS_H2 = 232 * MiB, WS_LOGITS = 264 * MiB, WS_SACT = 280 * MiB, WS_SHOUT = 288 * MiB;
constexpr size_t WS_LIST = 352 * MiB, WS_WTS = 368 * MiB, WS_ACT = 370 * MiB, WS_GST = 440 * MiB, WS_SLOTS = 480 * MiB, WS_XCH = 740 * MiB, WS_NAIVE = 744 * MiB;
constexpr int CW_TMO = 0, CW_CODE = 1, CW_BAR = 4096, CW_SEAM = 16384, SEAM_BANK = 128 * 64, CW_CNT = 49152  ;
constexpr int RING_OFF = 0, RING_BYTES = 131072, LDSCTL_OFF = RING_BYTES, MISC_OFF = LDSCTL_OFF + 320, LDS_BYTES = 147456;

typedef float f32x2_t __attribute__((ext_vector_type(2))); typedef __bf16 bf16x2_t __attribute__((ext_vector_type(2)));
__device__ __forceinline__ unsigned pkbf(float lo, float hi) { f32x2_t v = {lo, hi}; bf16x2_t b = __builtin_convertvector(v, bf16x2_t); return __builtin_bit_cast(unsigned, b); }
__device__ __forceinline__ float bf2f(unsigned short h) { return __uint_as_float((unsigned)h << 16); }
__device__ __forceinline__ float siluf(float v) { return v / (1.f + __expf(-v)); }
__device__ __forceinline__ float wave_sum(float v) {
#pragma unroll
    for (int o = 1; o < 64; o <<= 1) v += __shfl_xor(v, o);
    return v;
}

struct Frame {
    LAS unsigned char* lds;
    volatile LAS unsigned* MISC;
    gu32* ctl;
    int wave, vcu, G;
    unsigned char* ws;
    __device__ __forceinline__ int lane_id() const { return (int)__builtin_amdgcn_mbcnt_hi(~0u, __builtin_amdgcn_mbcnt_lo(~0u, 0u)); }
    __device__ __forceinline__ int tid_id() const { return wave * 64 + lane_id(); }
    __device__ __forceinline__ int tid_fresh() const { int l; asm volatile("v_mbcnt_lo_u32_b32 %0, -1, 0\n\tv_mbcnt_hi_u32_b32 %0, -1, %0" : "=v"(l)); return wave * 64 + l; }
};
#define FTID (F.tid_id())
#define FLANE (F.lane_id())

__device__ __forceinline__ void tr_writeout(bf16* WT, int K, int dst_row, int k0, LAS float* scr, int lane) {
    LDS_WAIT(); asm volatile("" ::: "memory");
    const int c = lane & 7;
#pragma unroll
    for (int j = 0; j < 4; ++j) { const int n = (lane >> 3) + 8 * j; const LAS float* s = scr + (8 * c) * 33 + n;
        v4u o; o.x = pk2(s[0 * 33], s[1 * 33]); o.y = pk2(s[2 * 33], s[3 * 33]); o.z = pk2(s[4 * 33], s[5 * 33]); o.w = pk2(s[6 * 33], s[7 * 33]);
        *(GAS v4u*)(WT + (size_t)(dst_row + n) * K + k0 + 8 * c) = o; }
    LDS_WAIT(); asm volatile("" ::: "memory");
}
__device__ __forceinline__ void tr_item(const float* W, int ldw, int col0, bf16* WT, int K, int dst_row0, int kb, int nb, LAS float* scr, int lane) {
    const int k0 = 64 * kb, n0 = 32 * nb;
#pragma unroll 8
    for (int i = 0; i < 32; ++i) { const int kk = 2 * i + (lane >> 5); scr[kk * 33 + (lane & 31)] = W[(size_t)(k0 + kk) * ldw + col0 + n0 + (lane & 31)]; }
    tr_writeout(WT, K, dst_row0 + n0, k0, scr, lane);
}
__device__ __forceinline__ void fold_item(const float* w_in, const float* w_up, bf16* WT, int kb, int nb, LAS float* scr, int lane) {
    const int k0 = 64 * kb, n0 = 32 * nb, n = n0 + (lane & 31);
    float wu[16];
#pragma unroll
    for (int r = 0; r < 16; ++r) wu[r] = w_up[r * 256 + n];
    for (int i = 0; i < 32; ++i) { const int kk = 2 * i + (lane >> 5); const float* wi = w_in + (size_t)(k0 + kk) * INW + 1024; float a = 0.f;
#pragma unroll
        for (int r = 0; r < 16; ++r) a += wi[r] * wu[r];
        scr[kk * 33 + (lane & 31)] = a; }
    tr_writeout(WT, 1024, 1024 + n0, k0, scr, lane);
}

struct P0In { const float *c, *w_ada, *b_ada, *w_in, *w_gk_up, *w_out, *w_router, *ws_gate, *ws_up, *ws_down; const int* positions; };
__device__ __forceinline__ void p0a_prep(Frame& F, const P0In& I) {
    bf16* W1t = (bf16*)(F.ws + WS_W1T); bf16* Wot = (bf16*)(F.ws + WS_WOT); bf16* W4t = (bf16*)(F.ws + WS_W4T); bf16* Wsdt = (bf16*)(F.ws + WS_WSDT);
    float* mod = (float*)(F.ws + WS_MOD); float* CS = (float*)(F.ws + WS_CS);
    if (F.vcu < 96) {
        const int n0 = 64 * F.vcu; float a0 = 0.f, a1 = 0.f;
        const float* wp = I.w_ada + (size_t)(128 * F.wave) * 6144 + n0 + FLANE;
#pragma unroll 8
        for (int k = 0; k < 128; ++k) { const float wv = wp[(size_t)k * 6144]; const int kk = 128 * F.wave + k;
            a0 += siluf(I.c[kk]) * wv; a1 += siluf(I.c[1024 + kk]) * wv; }
        LAS float* red = (LAS float*)(F.lds + RING_OFF + F.wave * 16384 + 12288);
        red[FLANE] = a0; red[64 + FLANE] = a1;
        LDS_WAIT(); __syncthreads();
        if (F.wave == 0) { float s0 = 0.f, s1 = 0.f;
#pragma unroll
            for (int w = 0; w < 8; ++w) { const LAS float* r = (const LAS float*)(F.lds + RING_OFF + w * 16384 + 12288); s0 += r[FLANE]; s1 += r[64 + FLANE]; }
            mod[n0 + FLANE] = s0 + I.b_ada[n0 + FLANE]; mod[6144 + n0 + FLANE] = s1 + I.b_ada[n0 + FLANE]; }
    }
    LAS float* scr = (LAS float*)(F.lds + RING_OFF + F.wave * 16384);
    const int gw = F.vcu * NWAVES + F.wave, NGW = F.G * NWAVES;
    for (int it = gw; it < 2304; it += NGW) {
        int r = it;
        if (r < 512) { tr_item(I.w_in, INW, 0, W1t, 1024, 0, r / 32, r % 32, scr, FLANE); continue; } r -= 512;
        if (r < 640) { tr_item(I.w_in, INW, 1040, W1t, 1024, 1280, r / 40, r % 40, scr, FLANE); continue; } r -= 640;
        if (r < 128) { fold_item(I.w_in, I.w_gk_up, W1t, r / 8, r % 8, scr, FLANE); continue; } r -= 128;
        if (r < 512) { tr_item(I.w_out, 1024, 0, Wot, 1024, 0, r / 32, r % 32, scr, FLANE); continue; } r -= 512;
        if (r < 128) { tr_item(I.w_router, 256, 0, W4t, 1024, 0, r / 8, r % 8, scr, FLANE); continue; } r -= 128;
        if (r < 64) { tr_item(I.ws_gate, 256, 0, W4t, 1024, 256, r / 4, r % 4, scr, FLANE); continue; } r -= 64;
        if (r < 64) { tr_item(I.ws_up, 256, 0, W4t, 1024, 384, r / 4, r % 4, scr, FLANE); continue; } r -= 64;
        if (r < 64) { tr_item(I.ws_gate, 256, 128, W4t, 1024, 512, r / 4, r % 4, scr, FLANE); continue; } r -= 64;
        if (r < 64) { tr_item(I.ws_up, 256, 128, W4t, 1024, 640, r / 4, r % 4, scr, FLANE); continue; } r -= 64;
        tr_item(I.ws_down, 1024, 0, Wsdt, 256, 0, r / 32, r % 32, scr, FLANE);
    }
    for (int idx = F.vcu * NTHREADS + FTID; idx < M * 8; idx += F.G * NTHREADS) {
        const int row = idx >> 3, i = idx & 7;
        const float inv_freq = powf(500000.0f, -(float)(2 * i) / 16.0f);
        const float ang = (float)I.positions[row] * inv_freq;
        CS[row * 16 + i] = cosf(ang); CS[row * 16 + 8 + i] = sinf(ang);
    }
}

__device__ __forceinline__ void norm_rows(Frame& F, const float* x, const float* g, int sh_off, int sc_off, bf16* XN) {
    const float* mod = (const float*)(F.ws + WS_MOD);
    const int gw = F.vcu * NWAVES + F.wave, NGW = F.G * NWAVES;
    for (int m = gw; m < M; m += NGW) {
        const GAS f32x4* xr = (const GAS f32x4*)(x + (size_t)m * D) + FLANE;
        f32x4 v[4]; float s = 0.f;
#pragma unroll
        for (int j = 0; j < 4; ++j) { v[j] = xr[64 * j]; s += (v[j].x * v[j].x + v[j].y * v[j].y) + (v[j].z * v[j].z + v[j].w * v[j].w); }
        const float r = rsqrtf(wave_sum(s) * (1.f / D) + EPS);
        const float* mb = mod + (m >> 13) * 6144;
        GAS unsigned long long* o8 = (GAS unsigned long long*)(XN + (size_t)m * D) + FLANE;
#pragma unroll
        for (int j = 0; j < 4; ++j) { const int c = 4 * FLANE + 256 * j;
            const f32x4 gg = *(const f32x4*)(g + c), sc = *(const f32x4*)(mb + sc_off + c), sh = *(const f32x4*)(mb + sh_off + c);
            const f32x4 o = v[j] * r * gg * (sc + 1.0f) + sh;
            o8[64 * j] = (unsigned long long)pk2(o.x, o.y) | ((unsigned long long)pk2(o.z, o.w) << 32); }
    }
}

struct EpiP1 {
    static constexpr bool PERM = true, AFTER_DRAIN = false;
    unsigned char* ws; const float* b_gk;
    __device__ __forceinline__ void operator()(const pg8::f32x4 (&acc)[2][2][4][2], const pg8::Unit& u, int wr, int wc, int fr, int fq) const {
        const int row0 = u.pm * 256 + wr * 64 + fr, cl0 = wc * 32 + 8 * fq, pn = u.pn;
        if (pn == 4) {
            float* LA = (float*)(ws + WS_LA);
#pragma unroll
            for (int bj = 0; bj < 2; ++bj) {
                const int col = bj * 128 + cl0;
                const f32x4 b0 = *(const f32x4*)(b_gk + col), b1 = *(const f32x4*)(b_gk + col + 4);
#pragma unroll
                for (int ai = 0; ai < 2; ++ai)
#pragma unroll
                    for (int m = 0; m < 4; ++m) {
                        const f32x4 z0 = acc[ai][bj][m][0] + b0, z1 = acc[ai][bj][m][1] + b1; f32x4 o0, o1;
#pragma unroll
                        for (int i = 0; i < 4; ++i) { o0[i] = (fminf(z0[i], 0.f) - __logf(1.f + __expf(-fabsf(z0[i])))) * 0.0625f; o1[i] = (fminf(z1[i], 0.f) - __logf(1.f + __expf(-fabsf(z1[i])))) * 0.0625f; }
                        float* dst = LA + (size_t)(row0 + ai * 128 + m * 16) * 256 + col;
                        *(f32x4*)dst = o0; *(f32x4*)(dst + 4) = o1;
                    }
            }
            return;
        }
        size_t boff; int ld, bjs = 128, mode = 0; float scale = 1.f;
        if (pn == 0) { boff = WS_GQ; ld = 256; scale = 0.125f; }
        else if (pn == 1) { boff = WS_GK; ld = 256; }
        else if (pn < 4) { boff = WS_GV + (size_t)(pn - 2) * 512; ld = 512; }
        else if (pn < 7) { boff = WS_SGR + (size_t)(pn - 5) * 512; ld = 512; mode = 1; }
        else if (pn < 9) { boff = WS_SQ + (size_t)(pn - 7) * 512; ld = 512; mode = 2; scale = QS; }
        else { boff = WS_SK; ld = 128; bjs = (int)((WS_SV - WS_SK) / 2); mode = 3; }
        bf16* base = (bf16*)(ws + boff) + cl0;
        const bool ropewave = (mode >= 2) && ((wc & 1) == 0);
        const float* CS = (const float*)(ws + WS_CS);
#pragma unroll
        for (int ai = 0; ai < 2; ++ai)
#pragma unroll
            for (int m = 0; m < 4; ++m) {
                const int row = row0 + ai * 128 + m * 16;
                f32x4 cs0, cs1, sn0, sn1;
                if (ropewave) { const f32x4* cp = (const f32x4*)(CS + (size_t)row * 16); cs0 = cp[0]; cs1 = cp[1]; sn0 = cp[2]; sn1 = cp[3]; }
#pragma unroll
                for (int bj = 0; bj < 2; ++bj) {
                    f32x4 v0 = acc[ai][bj][m][0], v1 = acc[ai][bj][m][1];
                    if (mode == 1) {
#pragma unroll
                        for (int i = 0; i < 4; ++i) { v0[i] = siluf(v0[i]); v1[i] = siluf(v1[i]); }
                    }
                    if (ropewave && (mode == 2 || bj == 0)) {
                        f32x4 p0, p1;
#pragma unroll
                        for (int i = 0; i < 4; ++i) { p0[i] = __shfl_xor(v0[i], 16); p1[i] = __shfl_xor(v1[i], 16); }
                        if (fq == 0) { v0 = v0 * cs0 - p0 * sn0; v1 = v1 * cs1 - p1 * sn1; }
                        else if (fq == 1) { v0 = v0 * cs0 + p0 * sn0; v1 = v1 * cs1 + p1 * sn1; }
                    }
                    v0 = v0 * scale; v1 = v1 * scale;
                    pg8::u32x4 w; w.x = pg8::cvt_pk_bf16(v0[0], v0[1]); w.y = pg8::cvt_pk_bf16(v0[2], v0[3]); w.z = pg8::cvt_pk_bf16(v1[0], v1[1]); w.w = pg8::cvt_pk_bf16(v1[2], v1[3]);
                    *(pg8::u32x4*)(base + (size_t)row * ld + bj * bjs) = w;
                }
            }
    }
};
struct EpiXmid {
    static constexpr bool PERM = false, AFTER_DRAIN = false;
    const float* x; const float* mod; float* xmid;
    __device__ __forceinline__ void operator()(const pg8::f32x4 (&acc)[2][2][4][2], const pg8::Unit& u, int wr, int wc, int fr, int fq) const {
        const int row0 = u.pm * 256 + wr * 64 + fr, col0 = u.pn * 256 + wc * 32 + 4 * fq;
        const float* gt = mod + (u.pm >> 5) * 6144 + 2048;
        pg8::f32x4 gv[2][2];
#pragma unroll
        for (int bj = 0; bj < 2; ++bj)
#pragma unroll
            for (int n = 0; n < 2; ++n) gv[bj][n] = *(const pg8::f32x4*)(gt + col0 + bj * 128 + n * 16);
#pragma unroll
        for (int ai = 0; ai < 2; ++ai)
#pragma unroll
            for (int m = 0; m < 4; ++m) { const size_t off = (size_t)(row0 + ai * 128 + m * 16) * D + col0;
#pragma unroll
                for (int bj = 0; bj < 2; ++bj)
#pragma unroll
                    for (int n = 0; n < 2; ++n) { const pg8::f32x4 xv = *(const pg8::f32x4*)(x + off + bj * 128 + n * 16);
                        *(pg8::f32x4*)(xmid + off + bj * 128 + n * 16) = xv + gv[bj][n] * acc[ai][bj][m][n]; } }
    }
};
struct EpiP4 {
    static constexpr bool PERM = true, AFTER_DRAIN = false;
    float* logits; bf16* sact;
    __device__ __forceinline__ void operator()(const pg8::f32x4 (&acc)[2][2][4][2], const pg8::Unit& u, int wr, int wc, int fr, int fq) const {
        const int row0 = u.pm * 256 + wr * 64 + fr, cl0 = wc * 32 + 8 * fq;
#pragma unroll
        for (int ai = 0; ai < 2; ++ai)
#pragma unroll
            for (int m = 0; m < 4; ++m) { const int row = row0 + ai * 128 + m * 16;
                if (u.pn == 0) {
#pragma unroll
                    for (int bj = 0; bj < 2; ++bj) { float* dst = logits + (size_t)row * 256 + bj * 128 + cl0; *(pg8::f32x4*)dst = acc[ai][bj][m][0]; *(pg8::f32x4*)(dst + 4) = acc[ai][bj][m][1]; }
                } else {
                    pg8::f32x4 a0 = acc[ai][0][m][0], a1 = acc[ai][0][m][1]; const pg8::f32x4 u0 = acc[ai][1][m][0], u1 = acc[ai][1][m][1];
#pragma unroll
                    for (int i = 0; i < 4; ++i) { a0[i] = siluf(a0[i]) * u0[i]; a1[i] = siluf(a1[i]) * u1[i]; }
                    pg8::u32x4 w; w.x = pg8::cvt_pk_bf16(a0[0], a0[1]); w.y = pg8::cvt_pk_bf16(a0[2], a0[3]); w.z = pg8::cvt_pk_bf16(a1[0], a1[1]); w.w = pg8::cvt_pk_bf16(a1[2], a1[3]);
                    *(pg8::u32x4*)(sact + (size_t)row * 256 + (u.pn - 1) * 128 + cl0) = w;
                }
            }
    }
};
struct EpiF32x {
    static constexpr bool PERM = false, AFTER_DRAIN = false;
    float* C; int ldc;
    __device__ __forceinline__ void operator()(const pg8::f32x4 (&acc)[2][2][4][2], const pg8::Unit& u, int wr, int wc, int fr, int fq) const {
        const int row0 = u.pm * 256 + wr * 64 + fr, col0 = u.pn * 256 + wc * 32 + 4 * fq;
#pragma unroll
        for (int ai = 0; ai < 2; ++ai)
#pragma unroll
            for (int m = 0; m < 4; ++m) { float* rowp = C + (size_t)(row0 + ai * 128 + m * 16) * ldc + col0;
#pragma unroll
                for (int bj = 0; bj < 2; ++bj)
#pragma unroll
                    for (int n = 0; n < 2; ++n) *(pg8::f32x4*)(rowp + bj * 128 + n * 16) = acc[ai][bj][m][n]; }
    }
};

__device__ __forceinline__ void route_tokens(Frame& F, const float* logits, const float* rbias, int* cnt, int* list, float* wts) {
    const int gw = F.vcu * NWAVES + F.wave, NGW = F.G * NWAVES, lane = FLANE;
    const f32x4 rb = *(const f32x4*)(rbias + lane * 4);
    for (int t0 = gw; t0 < M; t0 += 8 * NGW) {
        int my_e = 0, my_t = -1; float my_w = 0.f;
        for (int j = 0; j < 8; ++j) {
            const int t = t0 + j * NGW;
            if (t >= M) break;
            const f32x4 lg = *(const f32x4*)(logits + (size_t)t * 256 + lane * 4);
            const float sc0 = 1.f / (1.f + expf(-lg.x)), sc1 = 1.f / (1.f + expf(-lg.y)), sc2 = 1.f / (1.f + expf(-lg.z)), sc3 = 1.f / (1.f + expf(-lg.w));
            float s0 = sc0 + rb.x, s1 = sc1 + rb.y, s2 = sc2 + rb.z, s3 = sc3 + rb.w;
            float m1 = fmaxf(s0, s1), m2 = fminf(s0, s1);
            { const float n1 = fmaxf(m1, s2), n2 = fmaxf(fminf(m1, s2), m2); m1 = n1; m2 = n2; }
            { const float n1 = fmaxf(m1, s3), n2 = fmaxf(fminf(m1, s3), m2); m1 = n1; m2 = n2; }
#pragma unroll
            for (int off = 1; off < 8; off <<= 1) {
                const float o1 = __shfl_xor(m1, off), o2 = __shfl_xor(m2, off);
                const float n1 = fmaxf(m1, o1), n2 = fmaxf(fminf(m1, o1), fmaxf(m2, o2)); m1 = n1; m2 = n2;
            }
            const float gs = m1 + m2; const int myg = lane >> 3;
            int rank = 0;
#pragma unroll
            for (int g = 0; g < 8; ++g) { const float gj = __shfl(gs, g * 8); rank += (gj > gs || (gj == gs && g < myg)) ? 1 : 0; }
            if (rank >= 4) { s0 = -INFINITY; s1 = -INFINITY; s2 = -INFINITY; s3 = -INFINITY; }
            float wsum = 0.f, sel_s = 0.f; int sel_e = 0;
#pragma unroll
            for (int k = 0; k < 8; ++k) {
                float bv = s0; int bi = 0;
                if (s1 > bv) { bv = s1; bi = 1; }
                if (s2 > bv) { bv = s2; bi = 2; }
                if (s3 > bv) { bv = s3; bi = 3; }
                float v = bv; int e = lane * 4 + bi;
#pragma unroll
                for (int off = 32; off >= 1; off >>= 1) {
                    const float ov = __shfl_xor(v, off); const int oe = __shfl_xor(e, off);
                    if (ov > v || (ov == v && oe < e)) { v = ov; e = oe; }
                }
                const int ei = e & 3;
                const float mysc = ei == 0 ? sc0 : ei == 1 ? sc1 : ei == 2 ? sc2 : sc3;
                const float scw = __shfl(mysc, e >> 2);
                if (lane == (e >> 2)) { if (ei == 0) s0 = -INFINITY; else if (ei == 1) s1 = -INFINITY; else if (ei == 2) s2 = -INFINITY; else s3 = -INFINITY; }
                if (lane == 8 * j + k) { sel_e = e; sel_s = scw; }
                wsum += scw;
            }
            if ((lane >> 3) == j) { my_e = sel_e; my_w = sel_s / wsum * 2.5f; my_t = t; }
        }
        if (my_t >= 0) {
            const int pos = atomicAdd(&cnt[my_e * 64], 1);
            list[my_e * CAP + pos] = my_t * 8 + (lane & 7);
            wts[my_t * 8 + (lane & 7)] = my_w;
        }
    }
}

__device__ __forceinline__ f32x4 ld4(const float* p) { return *(const f32x4*)p; }
__device__ __forceinline__ f32x4 ld4(const bf16* p) { const unsigned long long w = *(const unsigned long long*)p;
    return (f32x4){bf2f((unsigned short)w), bf2f((unsigned short)(w >> 16)), bf2f((unsigned short)(w >> 32)), bf2f((unsigned short)(w >> 48))}; }
namespace moe {
constexpr int MOE_STAGGER_TICKS = 0;
constexpr int A_BYTES = 256 * 64, B_KG = 2240, B_BYTES = 8 * B_KG;
constexpr int OFF_A = 0, OFF_B = 2 * A_BYTES, OFF_ROW = OFF_B + 2 * B_BYTES, OFF_MAP = OFF_ROW + 2048, LDS_END = OFF_MAP + 3 * 260 * 4;
static_assert(LDS_END <= RING_BYTES, "moe LDS");
typedef short bf16x8 __attribute__((ext_vector_type(8)));
typedef short s16x4 __attribute__((ext_vector_type(4)));
typedef unsigned u32x2 __attribute__((ext_vector_type(2)));

struct Ctx { const bf16* H2; const float *wg, *wu, *wd; const int* list; const float* wts; bf16* ACT; bf16* SLOT; };

__device__ __forceinline__ void unit(Frame& F, const Ctx& C, int e, int mt, int cnt_e, int pos0) {
    LAS unsigned char* L = F.lds + RING_OFF;
    LAS int* rowent = (LAS int*)(L + OFF_ROW); LAS float* roww = (LAS float*)(L + OFF_ROW + 1024);
    if (MOE_STAGGER_TICKS > 0 && mt > 0) { const unsigned long long t0_ = __builtin_amdgcn_s_memrealtime(); while (__builtin_amdgcn_s_memrealtime() - t0_ < (unsigned long long)(mt * MOE_STAGGER_TICKS)) __builtin_amdgcn_s_sleep(8); }
    const int tid = F.tid_fresh();
    const int lane = tid & 63, wid = F.wave, wr = wid >> 2, wc = wid & 3, fr = lane & 15, fq = lane >> 4;
    const int mvalid = min(256, cnt_e - mt * 256);
    if (tid < 256) { const int ent = (tid < mvalid) ? C.list[(size_t)e * CAP + mt * 256 + tid] : -1; rowent[tid] = ent; roww[tid] = ent >= 0 ? C.wts[ent] : 0.f; }
    LDS_WAIT(); __syncthreads();
    const int ar0 = tid >> 2, ac = tid & 3;
    if (tid < 256 && tid >= mvalid) rowent[tid] = -1 - rowent[0];
    LDS_WAIT(); __syncthreads();
    const unsigned aw_off0 = (unsigned)(ar0 * 64 + ((ac ^ ((0 - (ar0 >> 2)) & 3)) * 16));
    const int hb = lane >> 5, l5 = lane & 31;
    const unsigned bw_off = (unsigned)(wid * B_KG + (32 * hb + 8 * (l5 >> 3) + 4 * (l5 & 1) + ((l5 >> 1) & 3)) * 8);
    const unsigned ar_off = (unsigned)((64 * wr + fr) * 64 + ((fq ^ ((0 - (fr >> 2)) & 3)) * 16));
    const unsigned br_off = (unsigned)(2 * fq * B_KG + (fr & 3) * 544 + (8 * wc + (fr >> 2)) * 8);

    const float *wg_ = C.wg, *wu_ = C.wu, *wd_ = C.wd; asm volatile("" : "+s"(wg_), "+s"(wu_), "+s"(wd_));
    const float* bbase1 = (hb ? wu_ : wg_) + (size_t)e * D * 256 + 4 * l5 + (size_t)(4 * wid) * 256;
    const float* bbase2 = wd_ + (size_t)e * 256 * D + hb * 128 + 4 * l5 + (size_t)(4 * wid) * D;
    const bf16* act0 = C.ACT + (size_t)pos0 * 256;
    f32x4 acc[2][2][4][2];
#define MOE_ZERO() do { _Pragma("unroll") for (int a_ = 0; a_ < 2; ++a_) _Pragma("unroll") for (int b_ = 0; b_ < 2; ++b_) _Pragma("unroll") for (int m_ = 0; m_ < 4; ++m_) \
        _Pragma("unroll") for (int n_ = 0; n_ < 2; ++n_) acc[a_][b_][m_][n_] = (f32x4){0.f, 0.f, 0.f, 0.f}; } while (0)
    v4u ra0[2], ra1[2]; f32x4 rb0[4], rb1[4];
#define MOE_LOADB(RB, x) do { const int x_ = (x); const float* p_; int ld_; \
        if (x_ < 64) { p_ = bbase1 + (x_ >> 5) * 128 + (size_t)((x_ & 31) * 32) * 256; ld_ = 256; } \
        else { const int y_ = x_ - 64; p_ = bbase2 + (y_ >> 3) * 256 + (size_t)((y_ & 7) * 32) * D; ld_ = D; } \
        _Pragma("unroll") for (int kk = 0; kk < 4; ++kk) RB[kk] = *(const f32x4*)(p_ + (size_t)kk * ld_); } while (0)
#define MOE_LOADA(RA, x) do { const int x_ = (x); \
        if (x_ < 64) { const int e0_ = rowent[ar0], e1_ = rowent[ar0 + 128]; const unsigned t0_ = (unsigned)((e0_ < 0 ? -1 - e0_ : e0_) >> 3), t1_ = (unsigned)((e1_ < 0 ? -1 - e1_ : e1_) >> 3); \
            RA[0] = *(const v4u*)(C.H2 + (size_t)t0_ * D + ac * 8 + (x_ & 31) * 32); RA[1] = *(const v4u*)(C.H2 + (size_t)t1_ * D + ac * 8 + (x_ & 31) * 32); } \
        else { RA[0] = *(const v4u*)(act0 + min(ar0, mvalid - 1) * 256 + ac * 8 + (x_ & 7) * 32); RA[1] = *(const v4u*)(act0 + min(ar0 + 128, mvalid - 1) * 256 + ac * 8 + (x_ & 7) * 32); } } while (0)
#define MOE_WRITE(buf, RA, RB) do { LAS unsigned char* Ab = L + OFF_A + (buf) * A_BYTES; LAS unsigned char* Bb = L + OFF_B + (buf) * B_BYTES; \
        *(LAS v4u*)(Ab + aw_off0) = RA[0]; *(LAS v4u*)(Ab + aw_off0 + 8192) = RA[1]; \
        _Pragma("unroll") for (int i = 0; i < 4; ++i) { u32x2 w_; w_.x = pkbf(RB[0][i], RB[1][i]); w_.y = pkbf(RB[2][i], RB[3][i]); *(LAS u32x2*)(Bb + bw_off + i * 544) = w_; } } while (0)
#define MOE_COMPUTE(xc) do { const int bsel_ = (xc) & 1; \
        const LAS unsigned char* Ab = L + OFF_A + bsel_ * A_BYTES + ar_off; const LAS unsigned char* Bb = L + OFF_B + bsel_ * B_BYTES + br_off; \
        bf16x8 bf[2][2]; \
        _Pragma("unroll") for (int bj = 0; bj < 2; ++bj) _Pragma("unroll") for (int n = 0; n < 2; ++n) { \
            const u32x2 lo = *(const LAS u32x2*)(Bb + bj * 256 + n * 32), hi = *(const LAS u32x2*)(Bb + bj * 256 + n * 32 + B_KG); \
            bf[bj][n] = __builtin_bit_cast(bf16x8, (v4u){lo.x, lo.y, hi.x, hi.y}); } \
        _Pragma("unroll") for (int ai = 0; ai < 2; ++ai) { bf16x8 af[4]; if (ai) __builtin_amdgcn_sched_barrier(0); \
            _Pragma("unroll") for (int m = 0; m < 4; ++m) af[m] = *(const LAS bf16x8*)(Ab + (128 * ai + 16 * m) * 64); \
            _Pragma("unroll") for (int m = 0; m < 4; ++m) _Pragma("unroll") for (int bj = 0; bj < 2; ++bj) _Pragma("unroll") for (int n = 0; n < 2; ++n) \
                acc[ai][bj][m][n] = __builtin_amdgcn_mfma_f32_16x16x32_bf16(bf[bj][n], af[m], acc[ai][bj][m][n], 0, 0, 0); } } while (0)
    const int cl0 = 32 * wc + 8 * fq;
#define MOE_EPILOGUE(pass) do { const int ps_ = (pass); \
        _Pragma("unroll") for (int ai = 0; ai < 2; ++ai) _Pragma("unroll") for (int m = 0; m < 4; ++m) { \
            const int r = 128 * ai + 64 * wr + 16 * m + fr; \
            if (r < mvalid) { \
                if (ps_ < 2) { \
                    f32x4 a0 = acc[ai][0][m][0], a1 = acc[ai][0][m][1]; const f32x4 u0 = acc[ai][1][m][0], u1 = acc[ai][1][m][1]; \
                    _Pragma("unroll") for (int i = 0; i < 4; ++i) { a0[i] = siluf(a0[i]) * u0[i]; a1[i] = siluf(a1[i]) * u1[i]; } \
                    v4u w_; w_.x = pkbf(a0[0], a0[1]); w_.y = pkbf(a0[2], a0[3]); w_.z = pkbf(a1[0], a1[1]); w_.w = pkbf(a1[2], a1[3]); \
                    *(v4u*)(C.ACT + (size_t)(pos0 + r) * 256 + ps_ * 128 + cl0) = w_; \
                } else { \
                    const float wgt = roww[r]; bf16* dst = C.SLOT + (size_t)rowent[r] * D + (ps_ - 2) * 256 + cl0; \
                    _Pragma("unroll") for (int bj = 0; bj < 2; ++bj) { const f32x4 a0 = acc[ai][bj][m][0] * wgt, a1 = acc[ai][bj][m][1] * wgt; \
                        v4u w_; w_.x = pkbf(a0[0], a0[1]); w_.y = pkbf(a0[2], a0[3]); w_.z = pkbf(a1[0], a1[1]); w_.w = pkbf(a1[2], a1[3]); \
                        *(v4u*)(dst + bj * 128) = w_; } \
                } } } \
        MOE_ZERO(); } while (0)
#define MOE_STEP(x, RAL, RBL, RAW, RBW) do { const int xs_ = (x); \
        if (xs_ + 2 < 96 && xs_ + 2 != 64 && xs_ + 2 != 65) MOE_LOADA(RAL, xs_ + 2); \
        if (xs_ + 2 < 96) MOE_LOADB(RBL, xs_ + 2); \
        MOE_COMPUTE(xs_); \
        if (xs_ == 31 || xs_ == 63 || (xs_ >= 71 && ((xs_ - 63) & 7) == 0)) { \
            const int ps_e = xs_ < 64 ? (xs_ >> 5) : 2 + ((xs_ - 64) >> 3); \
            MOE_EPILOGUE(ps_e); \
            if (xs_ == 63) { VM_WAIT(); __syncthreads(); MOE_LOADA(RAW, 64); MOE_LOADA(RAL, 65); } } \
        if (xs_ + 1 < 96) MOE_WRITE((xs_ + 1) & 1, RAW, RBW); \
        LDS_WAIT(); __syncthreads(); } while (0)
    MOE_LOADA(ra0, 0); MOE_LOADB(rb0, 0); MOE_LOADA(ra1, 1); MOE_LOADB(rb1, 1);
    MOE_WRITE(0, ra0, rb0);
    LDS_WAIT(); __syncthreads();
    MOE_ZERO();
    for (int x = 0; x < 96; x += 2) {
        MOE_STEP(x, ra0, rb0, ra1, rb1);
        MOE_STEP(x + 1, ra1, rb1, ra0, rb0);
    }
#undef MOE_ZERO
#undef MOE_LOADB
#undef MOE_LOADA
#undef MOE_WRITE
#undef MOE_COMPUTE
#undef MOE_EPILOGUE
#undef MOE_STEP
    __syncthreads();
}

__device__ __forceinline__ void phase(Frame& F, const Ctx& C, const int* cnt_g) {
    LAS unsigned char* L = F.lds + RING_OFF;
    LAS int* cnt = (LAS int*)(L + OFF_MAP); LAS int* offs = cnt + 260; LAS int* toff = offs + 260;
    if (FTID < NE) cnt[FTID] = cnt_g[FTID * 64];
    LDS_WAIT(); __syncthreads();
    if (FTID == 0) { int a = 0, b = 0; for (int e = 0; e < NE; ++e) { offs[e] = a; toff[e] = b; a += cnt[e]; b += (cnt[e] + 255) >> 8; } offs[NE] = a; toff[NE] = b; }
    LDS_WAIT(); __syncthreads();
    const int nunits = __builtin_amdgcn_readfirstlane(toff[NE]);
    int vcu = F.vcu;
    { const unsigned* bw = (const unsigned*)(F.ctl + CW_BAR); bool ok = (F.G % 8) == 0;
      for (int j = 0; j < 8; ++j) ok = ok && (__hip_atomic_load(bw + XB_XCNT(j), __ATOMIC_RELAXED, __HIP_MEMORY_SCOPE_AGENT) == (unsigned)(F.G / 8));
      const unsigned rk = F.MISC[10], xc = F.MISC[11];
      if (ok && xc < 8u && rk < (unsigned)(F.G / 8)) vcu = (int)(xc * (unsigned)(F.G / 8) + rk);
      vcu = __builtin_amdgcn_readfirstlane(vcu); }
    for (int u = vcu; u < nunits; u += F.G) {
        int lo = 0, hi = NE;
        while (hi - lo > 1) { const int mid = (lo + hi) >> 1; if (toff[mid] <= u) lo = mid; else hi = mid; }
        const int e = lo, mt = u - toff[lo];
        unit(F, C, e, mt, cnt[e], offs[e] + mt * 256);
    }
}
}

__device__ __forceinline__ void final_rows_slots(Frame& F, const float* xmid, const float* shout, const bf16* SLOT, const float* g, float* out) {
    const float* mod = (const float*)(F.ws + WS_MOD);
    const int gw = F.vcu * NWAVES + F.wave, NGW = F.G * NWAVES;
    for (int m = gw; m < M; m += NGW) {
        const size_t ro = (size_t)m * D;
        const float* gt = mod + (m >> 13) * 6144 + 5120;
        f32x4 v[4]; float s = 0.f;
#pragma unroll
        for (int j = 0; j < 4; ++j) { const int c = 4 * FLANE + 256 * j;
            f32x4 acc = *(const f32x4*)(shout + ro + c);
#pragma unroll
            for (int k = 0; k < 8; ++k) acc = acc + ld4(SLOT + ((size_t)m * 8 + k) * D + c);
            const f32x4 xv = *(const f32x4*)(xmid + ro + c), gg = *(const f32x4*)(gt + c);
            v[j] = xv + gg * acc; s += (v[j].x * v[j].x + v[j].y * v[j].y) + (v[j].z * v[j].z + v[j].w * v[j].w); }
        const float r = rsqrtf(wave_sum(s) * (1.f / D) + EPS);
#pragma unroll
        for (int j = 0; j < 4; ++j) { const int c = 4 * FLANE + 256 * j; const f32x4 gf = *(const f32x4*)(g + c); *(f32x4*)(out + ro + c) = v[j] * r * gf; }
    }
}
namespace gla {
typedef short bf16x8 __attribute__((ext_vector_type(8)));
typedef short s16x4 __attribute__((ext_vector_type(4)));
typedef unsigned u32x2 __attribute__((ext_vector_type(2)));
constexpr int LDW = 144;
constexpr int OFF_Q2 = 0, OFF_QI = 9216, OFF_KI = 18432, OFF_K2T = 27648, OFF_VT = 36864, OFF_ST = 55296, OFF_T = 73728, OFF_DEC = 75776, OFF_SS = 76032, LDS_END = 76544;
struct Ctx { const bf16 *GQ, *GK, *GV, *SGR; const float* LA; const float* g_out; float* GST; float* GDEC; bf16* OMIX; };

template <bool FULL>
__device__ __forceinline__ void chunk(Frame& F, const Ctx& C, int b, int h, size_t row0, f32x4 (&S)[4], float& sumtot) {
    LAS unsigned char* L = F.lds + RING_OFF;
    const int tid = FTID, lane = FLANE, w = F.wave, fr = lane & 15, fq = lane >> 4;
    const int d = tid & 63, g = w, dvv = tid & 127, jg = tid >> 7;
    float la[8], kk[8], qq[8]; unsigned short vv[16];
#pragma unroll
    for (int jj = 0; jj < 8; ++jj) { const size_t r = row0 + 8 * g + jj;
        la[jj] = C.LA[r * 256 + h * 64 + d]; kk[jj] = bf2f(C.GK[r * 256 + h * 64 + d]);
        if (FULL) qq[jj] = bf2f(C.GQ[r * 256 + h * 64 + d]); }
#pragma unroll
    for (int jj = 0; jj < 16; ++jj) vv[jj] = C.GV[(row0 + 16 * jg + jj) * 512 + h * 128 + dvv];
#pragma unroll
    for (int jj = 1; jj < 8; ++jj) la[jj] += la[jj - 1];
    LAS float* T = (LAS float*)(L + OFF_T);
    T[g * 64 + d] = la[7];
    LDS_WAIT(); __syncthreads();
    float P = 0.f, tot = 0.f, bref = 0.f;
#pragma unroll
    for (int gg = 0; gg < 8; ++gg) { const float t = T[gg * 64 + d]; if (gg < g) P += t; if (gg < 4) bref += t; tot += t; }
    sumtot += tot;
    {
        unsigned k2w[4];
#pragma unroll
        for (int jj = 0; jj < 8; jj += 2) {
            const float b0 = P + la[jj], b1 = P + la[jj + 1];
            k2w[jj >> 1] = pk2(kk[jj] * __expf(tot - b0), kk[jj + 1] * __expf(tot - b1));
            if (FULL) {
                const int j0 = 8 * g + jj;
                *(LAS unsigned short*)(L + OFF_Q2 + j0 * LDW + d * 2) = (unsigned short)f2bf(qq[jj] * __expf(b0));
                *(LAS unsigned short*)(L + OFF_Q2 + (j0 + 1) * LDW + d * 2) = (unsigned short)f2bf(qq[jj + 1] * __expf(b1));
                *(LAS unsigned short*)(L + OFF_QI + j0 * LDW + d * 2) = (unsigned short)f2bf(qq[jj] * __expf(b0 - bref));
                *(LAS unsigned short*)(L + OFF_QI + (j0 + 1) * LDW + d * 2) = (unsigned short)f2bf(qq[jj + 1] * __expf(b1 - bref));
                *(LAS unsigned short*)(L + OFF_KI + j0 * LDW + d * 2) = (unsigned short)f2bf(kk[jj] * __expf(bref - b0));
                *(LAS unsigned short*)(L + OFF_KI + (j0 + 1) * LDW + d * 2) = (unsigned short)f2bf(kk[jj + 1] * __expf(bref - b1));
            }
        }
        *(LAS v4u*)(L + OFF_K2T + d * LDW + 16 * g) = (v4u){k2w[0], k2w[1], k2w[2], k2w[3]};
        if (g == 0) ((LAS float*)(L + OFF_DEC))[d] = __expf(tot);
        v4u v0, v1;
        v0.x = vv[0] | ((unsigned)vv[1] << 16); v0.y = vv[2] | ((unsigned)vv[3] << 16); v0.z = vv[4] | ((unsigned)vv[5] << 16); v0.w = vv[6] | ((unsigned)vv[7] << 16);
        v1.x = vv[8] | ((unsigned)vv[9] << 16); v1.y = vv[10] | ((unsigned)vv[11] << 16); v1.z = vv[12] | ((unsigned)vv[13] << 16); v1.w = vv[14] | ((unsigned)vv[15] << 16);
        *(LAS v4u*)(L + OFF_VT + dvv * LDW + 32 * jg) = v0; *(LAS v4u*)(L + OFF_VT + dvv * LDW + 32 * jg + 16) = v1;
        if (FULL) {
#pragma unroll
            for (int nt = 0; nt < 4; ++nt) { u32x2 sw; sw.x = pk2(S[nt][0], S[nt][1]); sw.y = pk2(S[nt][2], S[nt][3]);
                *(LAS u32x2*)(L + OFF_ST + (16 * w + fr) * LDW + (16 * nt + 4 * fq) * 2) = sw; }
        }
    }
    LDS_WAIT(); __syncthreads();
    const int it = w >> 1, dvh = w & 1;
    f32x4 dO[4];
    if (FULL) {
        f32x4 dp[4];
#pragma unroll
        for (int nt = 0; nt < 4; ++nt) dp[nt] = (f32x4){0.f, 0.f, 0.f, 0.f};
#pragma unroll
        for (int ks = 0; ks < 2; ++ks) {
            const bf16x8 yq = *(const LAS bf16x8*)(L + OFF_QI + (16 * it + fr) * LDW + (32 * ks + 8 * fq) * 2);
#pragma unroll
            for (int nt = 0; nt < 4; ++nt) { const bf16x8 xk = *(const LAS bf16x8*)(L + OFF_KI + (16 * nt + fr) * LDW + (32 * ks + 8 * fq) * 2);
                dp[nt] = __builtin_amdgcn_mfma_f32_16x16x32_bf16(xk, yq, dp[nt], 0, 0, 0); }
        }
        const int iloc = 16 * it + fr;
#pragma unroll
        for (int nt = 0; nt < 4; ++nt)
#pragma unroll
            for (int r = 0; r < 4; ++r) if (16 * nt + 4 * fq + r > iloc) dp[nt][r] = 0.f;
        bf16x8 yp[2];
#pragma unroll
        for (int ks = 0; ks < 2; ++ks) { v4u pw; pw.x = pk2(dp[2 * ks][0], dp[2 * ks][1]); pw.y = pk2(dp[2 * ks][2], dp[2 * ks][3]); pw.z = pk2(dp[2 * ks + 1][0], dp[2 * ks + 1][1]); pw.w = pk2(dp[2 * ks + 1][2], dp[2 * ks + 1][3]);
            yp[ks] = __builtin_bit_cast(bf16x8, pw); }
#pragma unroll
        for (int dt = 0; dt < 4; ++dt) {
            dO[dt] = (f32x4){0.f, 0.f, 0.f, 0.f};
            const LAS unsigned char* vrow = L + OFF_VT + (64 * dvh + 16 * dt + fr) * LDW;
            const LAS unsigned char* srow = L + OFF_ST + (64 * dvh + 16 * dt + fr) * LDW;
#pragma unroll
            for (int ks = 0; ks < 2; ++ks) {
                const u32x2 lo = *(const LAS u32x2*)(vrow + (32 * ks + 4 * fq) * 2), hi = *(const LAS u32x2*)(vrow + (32 * ks + 16 + 4 * fq) * 2);
                const bf16x8 xv = __builtin_bit_cast(bf16x8, (v4u){lo.x, lo.y, hi.x, hi.y});
                dO[dt] = __builtin_amdgcn_mfma_f32_16x16x32_bf16(xv, yp[ks], dO[dt], 0, 0, 0);
                const bf16x8 xs = *(const LAS bf16x8*)(srow + (32 * ks + 8 * fq) * 2);
                const bf16x8 y2 = *(const LAS bf16x8*)(L + OFF_Q2 + (16 * it + fr) * LDW + (32 * ks + 8 * fq) * 2);
                dO[dt] = __builtin_amdgcn_mfma_f32_16x16x32_bf16(xs, y2, dO[dt], 0, 0, 0);
            }
        }
    }
    {
        f32x4 dU[4];
#pragma unroll
        for (int nt = 0; nt < 4; ++nt) dU[nt] = (f32x4){0.f, 0.f, 0.f, 0.f};
#pragma unroll
        for (int ks = 0; ks < 2; ++ks) {
            const bf16x8 yv = *(const LAS bf16x8*)(L + OFF_VT + (16 * w + fr) * LDW + (32 * ks + 8 * fq) * 2);
#pragma unroll
            for (int nt = 0; nt < 4; ++nt) { const bf16x8 xk = *(const LAS bf16x8*)(L + OFF_K2T + (16 * nt + fr) * LDW + (32 * ks + 8 * fq) * 2);
                dU[nt] = __builtin_amdgcn_mfma_f32_16x16x32_bf16(xk, yv, dU[nt], 0, 0, 0); }
        }
#pragma unroll
        for (int nt = 0; nt < 4; ++nt) { const f32x4 dc = *(const LAS f32x4*)(L + OFF_DEC + (16 * nt + 4 * fq) * 4); S[nt] = dc * S[nt] + dU[nt]; }
    }
    if (FULL) {
        float ss = 0.f;
#pragma unroll
        for (int dt = 0; dt < 4; ++dt) ss += (dO[dt][0] * dO[dt][0] + dO[dt][1] * dO[dt][1]) + (dO[dt][2] * dO[dt][2] + dO[dt][3] * dO[dt][3]);
        ss += __shfl_xor(ss, 16); ss += __shfl_xor(ss, 32);
        LAS float* SS = (LAS float*)(L + OFF_SS);
        if (fq == 0) SS[dvh * 64 + 16 * it + fr] = ss;
        LDS_WAIT(); __syncthreads();
        const float r = rsqrtf((SS[16 * it + fr] + SS[64 + 16 * it + fr]) * (1.f / 128.f) + EPS);
        const size_t row = row0 + 16 * it + fr;
#pragma unroll
        for (int dt = 0; dt < 4; ++dt) { const int dv0 = 64 * dvh + 16 * dt + 4 * fq;
            const f32x4 g4 = *(const f32x4*)(C.g_out + dv0); const f32x4 sg = ld4(C.SGR + row * 512 + h * 128 + dv0);
            const f32x4 o = dO[dt] * r * g4 * sg;
            u32x2 ow; ow.x = pk2(o[0], o[1]); ow.y = pk2(o[2], o[3]);
            *(u32x2*)(C.OMIX + row * 1024 + h * 128 + dv0) = ow; }
    }
    LDS_WAIT(); __syncthreads();
}

template <bool FULL>
__device__ __forceinline__ void phase(Frame& F, const Ctx& C) {
    const int lane = FLANE, w = F.wave, fr = lane & 15, fq = lane >> 4;
    for (int unit = F.vcu; unit < 256; unit += F.G) {
        const int bh = unit >> 5, seg = unit & 31, b = bh >> 2, h = bh & 3;
        f32x4 S[4];
#pragma unroll
        for (int nt = 0; nt < 4; ++nt) S[nt] = (f32x4){0.f, 0.f, 0.f, 0.f};
        float sumtot = 0.f;
        if (FULL && seg > 0) {
            LAS unsigned char* L = F.lds + RING_OFF;
            LAS float* Dd = (LAS float*)L; LAS float* Wt = (LAS float*)(L + 8192);
            { const int r0 = FTID >> 6, dd = FTID & 63;
#pragma unroll
              for (int j = 0; j < 4; ++j) { const int r = r0 + 8 * j; if (r < seg) Dd[r * 64 + dd] = C.GDEC[(bh * 32 + r) * 64 + dd]; } }
            LDS_WAIT(); __syncthreads();
            if (w == 0) { float wq = 1.f; for (int q = seg - 1; q >= 0; --q) { Wt[q * 64 + lane] = wq; wq *= Dd[q * 64 + lane]; } }
            LDS_WAIT(); __syncthreads();
            for (int q0 = 0; q0 < seg; q0 += 4) {
                f32x4 uu[4][4];
#pragma unroll
                for (int u = 0; u < 4; ++u) { const int q = min(q0 + u, seg - 1);
#pragma unroll
                    for (int nt = 0; nt < 4; ++nt) uu[u][nt] = *(const f32x4*)(C.GST + (size_t)(bh * 32 + q) * 8192 + (16 * w + fr) * 64 + 16 * nt + 4 * fq); }
#pragma unroll
                for (int u = 0; u < 4; ++u) if (q0 + u < seg) {
#pragma unroll
                    for (int nt = 0; nt < 4; ++nt) { const f32x4 wt = *(const LAS f32x4*)(Wt + (q0 + u) * 64 + 16 * nt + 4 * fq); S[nt] = S[nt] + wt * uu[u][nt]; } }
            }
        }
        for (int c = 0; c < 4; ++c) chunk<FULL>(F, C, b, h, (size_t)b * SEQ + seg * 256 + c * 64, S, sumtot);
        if (!FULL) {
#pragma unroll
            for (int nt = 0; nt < 4; ++nt) *(f32x4*)(C.GST + (size_t)unit * 8192 + (16 * w + fr) * 64 + 16 * nt + 4 * fq) = S[nt];
            if (w == 0) C.GDEC[unit * 64 + (FTID & 63)] = __expf(sumtot);
        }
    }
}
}
namespace swa {
typedef short bf16x8 __attribute__((ext_vector_type(8)));
typedef short s16x4 __attribute__((ext_vector_type(4)));
typedef unsigned u32x2 __attribute__((ext_vector_type(2)));
constexpr int KLD = 144, VLD = 528, OFF_K = 0, OFF_VT = 256 * KLD, LDS_END = OFF_VT + 64 * VLD;
static_assert(LDS_END <= RING_BYTES, "swa LDS");

__device__ __forceinline__ void phase(Frame& F, const bf16* SQ, const bf16* SK, const bf16* SV, const float* sinks, bf16* OMIX) {
    LAS unsigned char* L = F.lds + RING_OFF;
    const int tid = FTID, lane = FLANE, w = F.wave, fr = lane & 15, fq = lane >> 4;
    for (int unit = F.vcu; unit < 256; unit += F.G) {
        const int qb = unit & 63, kvh = (unit >> 6) & 1, b = unit >> 7;
        const int t0 = qb * 128, kstart = t0 - 128;
#pragma unroll
        for (int j = 0; j < 4; ++j) {
            const int p = tid + 512 * j, key = p >> 3, ch = p & 7, tok = kstart + key;
            v4u kv = (v4u){0u, 0u, 0u, 0u}, vv = (v4u){0u, 0u, 0u, 0u};
            if (tok >= 0) { const size_t off = ((size_t)b * SEQ + tok) * 128 + kvh * 64 + ch * 8; kv = *(const v4u*)(SK + off); vv = *(const v4u*)(SV + off); }
            *(LAS v4u*)(L + OFF_K + key * KLD + ch * 16) = kv;
            const unsigned vw[4] = {vv.x, vv.y, vv.z, vv.w};
#pragma unroll
            for (int e = 0; e < 8; ++e) *(LAS unsigned short*)(L + OFF_VT + (ch * 8 + e) * VLD + key * 2) = (unsigned short)(vw[e >> 1] >> ((e & 1) * 16));
        }
        LDS_WAIT(); __syncthreads();
        const int hq = 4 * kvh + (w >> 1);
        const float sink2 = sinks[hq] * LOG2E;
        for (int qt = 0; qt < 4; ++qt) {
            const int i0 = (w & 1) * 64 + 16 * qt, T0 = i0 >> 4, i = i0 + fr;
            const size_t qrow = (size_t)b * SEQ + t0 + i;
            bf16x8 yq[2];
#pragma unroll
            for (int ks = 0; ks < 2; ++ks) yq[ks] = *(const bf16x8*)(SQ + qrow * 512 + hq * 64 + 32 * ks + 8 * fq);
            f32x4 ds[10];
#pragma unroll
            for (int nt = 0; nt < 10; ++nt) {
                ds[nt] = (f32x4){0.f, 0.f, 0.f, 0.f};
                const int kt = min(T0 + nt, 15);
#pragma unroll
                for (int ks = 0; ks < 2; ++ks) { const bf16x8 xk = *(const LAS bf16x8*)(L + OFF_K + (16 * kt + fr) * KLD + (32 * ks + 8 * fq) * 2);
                    ds[nt] = __builtin_amdgcn_mfma_f32_16x16x32_bf16(xk, yq[ks], ds[nt], 0, 0, 0); }
            }
            float mx = sink2;
#pragma unroll
            for (int nt = 0; nt < 10; ++nt)
#pragma unroll
                for (int r = 0; r < 4; ++r) { const int kj = 16 * (T0 + nt) + 4 * fq + r;
                    const bool valid = (kj >= i + 1) && (kj <= i + 128) && (kstart + kj >= 0);
                    ds[nt][r] = valid ? ds[nt][r] : -INFINITY; mx = fmaxf(mx, ds[nt][r]); }
            mx = fmaxf(mx, __shfl_xor(mx, 16)); mx = fmaxf(mx, __shfl_xor(mx, 32));
            float l = 0.f;
#pragma unroll
            for (int nt = 0; nt < 10; ++nt)
#pragma unroll
                for (int r = 0; r < 4; ++r) { const float p = exp2f(ds[nt][r] - mx); ds[nt][r] = p; l += p; }
            l += __shfl_xor(l, 16); l += __shfl_xor(l, 32);
            l += exp2f(sink2 - mx);
            const float il = 1.f / l;
            bf16x8 yp[5];
#pragma unroll
            for (int ks = 0; ks < 5; ++ks) { v4u pw; pw.x = pk2(ds[2 * ks][0], ds[2 * ks][1]); pw.y = pk2(ds[2 * ks][2], ds[2 * ks][3]); pw.z = pk2(ds[2 * ks + 1][0], ds[2 * ks + 1][1]); pw.w = pk2(ds[2 * ks + 1][2], ds[2 * ks + 1][3]);
                yp[ks] = __builtin_bit_cast(bf16x8, pw); }
#pragma unroll
            for (int dt = 0; dt < 4; ++dt) {
                f32x4 o = (f32x4){0.f, 0.f, 0.f, 0.f};
                const LAS unsigned char* vrow = L + OFF_VT + (16 * dt + fr) * VLD;
#pragma unroll
                for (int ks = 0; ks < 5; ++ks) {
                    const int ka = min(T0 + 2 * ks, 15), kb = min(T0 + 2 * ks + 1, 15);
                    const u32x2 lo = *(const LAS u32x2*)(vrow + (16 * ka + 4 * fq) * 2), hi = *(const LAS u32x2*)(vrow + (16 * kb + 4 * fq) * 2);
                    const bf16x8 xv = __builtin_bit_cast(bf16x8, (v4u){lo.x, lo.y, hi.x, hi.y});
                    o = __builtin_amdgcn_mfma_f32_16x16x32_bf16(xv, yp[ks], o, 0, 0, 0);
                }
                o = o * il;
                u32x2 ow; ow.x = pk2(o[0], o[1]); ow.y = pk2(o[2], o[3]);
                *(u32x2*)(OMIX + qrow * 1024 + 512 + hq * 64 + 16 * dt + 4 * fq) = ow;
            }
        }
        LDS_WAIT(); __syncthreads();
    }
}
}
struct Args { const void* in[22]; float* out; unsigned char* ws; int ph_lo, ph_hi, li, rep; };
enum { PH_PREP = 0, PH_XN = 1, PH_INPROJ = 2, PH_MIX = 3, PH_MIX2 = 4, PH_OUTPROJ = 5, PH_NORM2 = 6, PH_FFN1 = 7, PH_ROUTE = 8, PH_MOE = 9, PH_FINAL = 10, PH_END = 11 };

__global__ void __launch_bounds__(NTHREADS, 2) mega_fwd(Args args) {
    extern __shared__ __attribute__((aligned(16))) unsigned char lds[];
    Frame F;
    F.lds = (LAS unsigned char*)lds;
    F.MISC = (volatile LAS unsigned*)(F.lds + MISC_OFF);
    F.wave = __builtin_amdgcn_readfirstlane((int)threadIdx.x >> 6);
    F.G = gridDim.x; { const int bx = blockIdx.x; F.vcu = (F.G % 8 == 0) ? (bx % 8) * (F.G / 8) + bx / 8 : bx; }
    F.ws = args.ws; F.ctl = (gu32*)(args.ws + WS_CTL);
    for (int u = (int)threadIdx.x; u < (LDS_BYTES - LDSCTL_OFF) / 4; u += NTHREADS) ((LAS unsigned*)(F.lds + LDSCTL_OFF))[u] = 0u;
    __syncthreads();
    XcdBarrier bar = xcd_barrier_post((unsigned*)(F.ctl + CW_BAR) + args.li * XCD_BAR_WORDS, F.MISC + 8);
    const int lo = args.ph_lo, hi = args.ph_hi;
#define IN(k) (lo <= (k) && (k) < hi)
#define BOTH(k) (IN(k) && IN((k) + 1))
#define SEAM(k) do { if (BOTH(k)) xcd_barrier(bar); } while (0)
    const float* x = (const float*)args.in[0];
    unsigned char* ws = F.ws;
    int* cnt = (int*)(ws + WS_CTL) + CW_CNT; int* list = (int*)(ws + WS_LIST); float* wts = (float*)(ws + WS_WTS);

    if (IN(PH_PREP)) {
        P0In I{(const float*)args.in[1], (const float*)args.in[3], (const float*)args.in[4], (const float*)args.in[6], (const float*)args.in[7], (const float*)args.in[11],
               (const float*)args.in[13], (const float*)args.in[18], (const float*)args.in[19], (const float*)args.in[20], (const int*)args.in[2]};
        p0a_prep(F, I);
        SEAM(PH_PREP);
    }
    if (IN(PH_XN)) {
        norm_rows(F, x, (const float*)args.in[5], 0, 1024, (bf16*)(ws + WS_XN));
        SEAM(PH_XN);
    }
    if (IN(PH_INPROJ)) {
        pg8::Gemm g{(const pg8::bf16_t*)(ws + WS_XN), (const pg8::bf16_t*)(ws + WS_W1T), M, N1, D};
        pg8::StaticOrder S; S.init(M, N1, F.G, (int)blockIdx.x);
        EpiP1 E{ws, (const float*)args.in[8]};
        pg8::gemm_phase<EpiP1, pg8::StaticOrder, true, true>(F.lds + RING_OFF, g, S, E);
        SEAM(PH_INPROJ);
    }
    const gla::Ctx GC{(const bf16*)(ws + WS_GQ), (const bf16*)(ws + WS_GK), (const bf16*)(ws + WS_GV), (const bf16*)(ws + WS_SGR), (const float*)(ws + WS_LA), (const float*)args.in[9],
                      (float*)(ws + WS_GST), (float*)(ws + WS_GST + 8 * MiB), (bf16*)(ws + WS_OMIX)};
    if (IN(PH_MIX)) {
        gla::phase<false>(F, GC);
        swa::phase(F, (const bf16*)(ws + WS_SQ), (const bf16*)(ws + WS_SK), (const bf16*)(ws + WS_SV), (const float*)args.in[10], (bf16*)(ws + WS_OMIX));
        SEAM(PH_MIX);
    }
    if (IN(PH_MIX2)) {
        gla::phase<true>(F, GC);
        SEAM(PH_MIX2);
    }
    if (IN(PH_OUTPROJ)) {
        pg8::Gemm g{(const pg8::bf16_t*)(ws + WS_OMIX), (const pg8::bf16_t*)(ws + WS_WOT), M, D, D};
        pg8::StaticOrder S; S.init(M, D, F.G, (int)blockIdx.x);
        EpiXmid E{x, (const float*)(ws + WS_MOD), (float*)(ws + WS_XMID)};
        pg8::gemm_phase<EpiXmid, pg8::StaticOrder, true, true>(F.lds + RING_OFF, g, S, E);
        SEAM(PH_OUTPROJ);
    }
    if (IN(PH_NORM2)) {
        norm_rows(F, (const float*)(ws + WS_XMID), (const float*)args.in[12], 3072, 4096, (bf16*)(ws + WS_H2));
        SEAM(PH_NORM2);
    }
    if (IN(PH_FFN1)) {
        pg8::Gemm g{(const pg8::bf16_t*)(ws + WS_H2), (const pg8::bf16_t*)(ws + WS_W4T), M, 768, D};
        pg8::StaticOrder S; S.init(M, 768, F.G, (int)blockIdx.x);
        EpiP4 E{(float*)(ws + WS_LOGITS), (bf16*)(ws + WS_SACT)};
        pg8::gemm_phase<EpiP4, pg8::StaticOrder, true, true>(F.lds + RING_OFF, g, S, E);
        SEAM(PH_FFN1);
    }
    if (IN(PH_ROUTE)) {
        route_tokens(F, (const float*)(ws + WS_LOGITS), (const float*)args.in[14], cnt, list, wts);
        pg8::Gemm g{(const pg8::bf16_t*)(ws + WS_SACT), (const pg8::bf16_t*)(ws + WS_WSDT), M, D, 256};
        pg8::StaticOrder S; S.init(M, D, F.G, (int)blockIdx.x);
        EpiF32x E{(float*)(ws + WS_SHOUT), D};
        pg8::gemm_phase<EpiF32x, pg8::StaticOrder, true, true>(F.lds + RING_OFF, g, S, E);
        SEAM(PH_ROUTE);
    }
    if (IN(PH_MOE)) {
        moe::Ctx C{(const bf16*)(ws + WS_H2), (const float*)args.in[15], (const float*)args.in[16], (const float*)args.in[17], list, wts, (bf16*)(ws + WS_ACT), (bf16*)(ws + WS_SLOTS)};
        moe::phase(F, C, cnt);
        SEAM(PH_MOE);
    }
    if (IN(PH_FINAL)) {
        final_rows_slots(F, (const float*)(ws + WS_XMID), (const float*)(ws + WS_SHOUT), (const bf16*)(ws + WS_SLOTS), (const float*)args.in[21], args.out);
    }
#undef IN
#undef BOTH
#undef SEAM
}
constexpr int PROBE_REP = -1;
extern "C" void kernel_launch(void* const* d_in, const int* in_sizes, int n_in, void* d_out, int out_size, void* d_ws, size_t ws_size, hipStream_t stream) {
    static int grid = 0;
    if (grid == 0) {
        if (n_in != 22 || out_size != M * D || ws_size < (size_t)1000 * MiB) { fprintf(stderr, "kernel_launch: unexpected shapes (n_in %d, out %d, ws %zu)\n", n_in, out_size, ws_size); grid = -1; return; }
        int dev = 0, cus = 0, per_cu = 0;
        if (hipGetDevice(&dev) != hipSuccess || hipDeviceGetAttribute(&cus, hipDeviceAttributeMultiprocessorCount, dev) != hipSuccess) { grid = -1; return; }
        if (hipFuncSetAttribute((const void*)mega_fwd, hipFuncAttributeMaxDynamicSharedMemorySize, LDS_BYTES) != hipSuccess) { fprintf(stderr, "kernel_launch: hipFuncSetAttribute failed\n"); grid = -1; return; }
        if (hipOccupancyMaxActiveBlocksPerMultiprocessor(&per_cu, (const void*)mega_fwd, NTHREADS, LDS_BYTES) != hipSuccess || per_cu < 1) fprintf(stderr, "kernel_launch: occupancy query reports %d\n", per_cu);
        (void)hipGetLastError();
        grid = cus;
    }
    if (grid < 0) return;
    unsigned char* ws = (unsigned char*)d_ws;
    (void)hipMemsetAsync(ws + WS_CTL, 0, CTL_ZERO_BYTES, stream);
    Args a{};
    for (int i = 0; i < 22; ++i) a.in[i] = d_in[i];
    a.out = (float*)d_out; a.ws = ws;
    a.ph_lo = 0; a.ph_hi = PH_END; a.li = 0; a.rep = 0;
    hipLaunchKernelGGL(mega_fwd, dim3(grid), dim3(NTHREADS), LDS_BYTES, stream, a);
    if (PROBE_REP >= 0) { a.ph_lo = PROBE_REP; a.ph_hi = PROBE_REP + 1; a.li = 1; hipLaunchKernelGGL(mega_fwd, dim3(grid), dim3(NTHREADS), LDS_BYTES, stream, a); }
}
```

```cpp
#include <hip/hip_runtime.h>
#include <cstdio>
#include <cstdint>
#include <math.h>
namespace pg8 {
#define PG8_LAS __attribute__((address_space(3)))
typedef unsigned short bf16_t;
typedef short bf16x8 __attribute__((ext_vector_type(8)));
typedef float f32x4 __attribute__((ext_vector_type(4)));
typedef unsigned u32x4 __attribute__((ext_vector_type(4)));
constexpr int BM = 256, BK = 64, HALF = 128, HTB = HALF * BK * 2  , STAGE_BYTES = 8 * HTB, NXCD = 8, WGM = 8;

__host__ __device__ __forceinline__ int lds_byte(int r, int c) { const int st = (r >> 4) * 2 + (c >> 5), rr = r & 15, cc = c & 31, ob = rr * 64 + cc * 2; return st * 1024 + (ob ^ (((ob >> 9) & 1) << 5)); }
__host__ __device__ __forceinline__ void stage_rc(int b, int& R, int& C) { const int st = b / 1024, sb = b % 1024, swz = sb ^ (((sb >> 9) & 1) << 5); R = (st >> 1) * 16 + swz / 64; C = (st & 1) * 32 + (swz % 64) / 2; }
__host__ __device__ __forceinline__ int perm32(int rho) { const int n = rho >> 4, i = rho & 15; return 8 * (i >> 2) + 4 * n + (i & 3); }

struct Unit { int pm, pn; };
struct Gemm { const bf16_t* A; const bf16_t* Bt; int M, N, K; };

struct StaticOrder {
    int nM, nN, nwg, G, c;
    __host__ __device__ void init(int M, int N, int G_, int c_) { nM = M / BM; nN = N / BM; nwg = nM * nN; G = G_; c = c_; }
    __host__ __device__ bool next(int i, Unit& u) const {
        const long L = (long)i * G + c; if (L >= nwg) return false;
        int wgid = (int)L; { const int q = nwg / NXCD, r = nwg % NXCD, xcd = wgid % NXCD, off = wgid / NXCD; wgid = (xcd < r ? xcd * (q + 1) : r * (q + 1) + (xcd - r) * q) + off; }
        const int nig = WGM * nN, gid = wgid / nig, fm = gid * WGM, gsz = (nM - fm) < WGM ? (nM - fm) : WGM;
        u.pm = fm + ((wgid % nig) % gsz); u.pn = (wgid % nig) / gsz; return true;
    }
    __device__ __forceinline__ void a_ready(const Unit&) const {}
    __device__ __forceinline__ void done(const Unit&) const {}
};

__device__ __forceinline__ unsigned cvt_pk_bf16(float lo, float hi) { unsigned r; asm volatile("v_cvt_pk_bf16_f32 %0, %1, %2" : "=v"(r) : "v"(lo), "v"(hi)); return r; }
typedef float f32x2 __attribute__((ext_vector_type(2)));
__device__ __forceinline__ f32x2 gelu_pk(f32x2 v) {
    const f32x2 av = __builtin_elementwise_abs(v), d = av * 0.2316418882f + 1.0f;
    f32x2 t; t.x = __builtin_amdgcn_rcpf(d.x); t.y = __builtin_amdgcn_rcpf(d.y);
    f32x2 q = t * 0.5307027145f + (-0.7265760135f); q = q * t + 0.7107068705f; q = q * t + (-0.142248368f); q = q * t + 0.127414796f; q = q * t;
    const f32x2 s = (v * v) * (-0.72134752044f);
    f32x2 e; e.x = __builtin_amdgcn_exp2f(s.x); e.y = __builtin_amdgcn_exp2f(s.y);
    const f32x2 m = v * (q * e), r = v - m;
    f32x2 o; o.x = v.x < 0.f ? m.x : r.x; o.y = v.y < 0.f ? m.y : r.y; return o;
}

template <int ACT  > struct EpiBf16 {
    static constexpr bool PERM = true, AFTER_DRAIN = false; static_assert(ACT == 0 || ACT == 1, "EpiBf16: ACT is 0 (none) or 1 (gelu_pk)");
    bf16_t* O; int ldc; const float* bias; int split_cols; size_t split_stride; float scale0;
    __device__ __forceinline__ void operator()(const f32x4 (&acc)[2][2][4][2], const Unit& u, int wr, int wc, int fr, int fq) const {
        const int row0 = u.pm * BM + wr * 64 + fr; int colt = u.pn * BM; bf16_t* base = O;
        float sc = 1.f; if (split_cols) { const int t = colt / split_cols; base += (size_t)t * split_stride; colt -= t * split_cols; if (t == 0) sc = scale0; }
        const int col0 = colt + wc * 32 + 8 * fq, bcol0 = u.pn * BM + wc * 32 + 8 * fq;
        f32x4 bv[2][2];
#pragma unroll
        for (int bj = 0; bj < 2; ++bj)
#pragma unroll
            for (int n = 0; n < 2; ++n) bv[bj][n] = bias ? *(const f32x4*)(bias + bcol0 + bj * HALF + 4 * n) : (f32x4){0.f, 0.f, 0.f, 0.f};
#pragma unroll
        for (int ai = 0; ai < 2; ++ai)
#pragma unroll
            for (int m = 0; m < 4; ++m) { bf16_t* rowp = base + (size_t)(row0 + ai * HALF + m * 16) * ldc + col0;
#pragma unroll
                for (int bj = 0; bj < 2; ++bj) { f32x4 v0 = acc[ai][bj][m][0] + bv[bj][0], v1 = acc[ai][bj][m][1] + bv[bj][1];
                    if (ACT == 1) { f32x2 a = gelu_pk((f32x2){v0[0], v0[1]}), b = gelu_pk((f32x2){v0[2], v0[3]}), c = gelu_pk((f32x2){v1[0], v1[1]}), d = gelu_pk((f32x2){v1[2], v1[3]});
                        v0 = (f32x4){a.x, a.y, b.x, b.y}; v1 = (f32x4){c.x, c.y, d.x, d.y}; }
                    v0 = v0 * sc; v1 = v1 * sc; u32x4 w; w.x = cvt_pk_bf16(v0[0], v0[1]); w.y = cvt_pk_bf16(v0[2], v0[3]); w.z = cvt_pk_bf16(v1[0], v1[1]); w.w = cvt_pk_bf16(v1[2], v1[3]);
                    *(u32x4*)(rowp + bj * HALF) = w; } }
    }
};

struct PanelStats {
    unsigned* xbuf;
    unsigned* cnt;
    unsigned* tmo;
    int ntn; float eps;
    unsigned code;
    __device__ __forceinline__ bool run(const f32x4 (&v)[2][2][4][2], const Unit& u, int wr, int wc, int fr, int fq, PG8_LAS unsigned char* lds, int wid, int lane) const {
        typedef float f32x2v __attribute__((ext_vector_type(2)));
        PG8_LAS f32x2v* P = (PG8_LAS f32x2v*)lds;
        PG8_LAS f32x2v* S = (PG8_LAS f32x2v*)(lds + 8192);
        PG8_LAS unsigned* flag = (PG8_LAS unsigned*)(lds + 8192 + 2048);
#pragma unroll
        for (int ai = 0; ai < 2; ++ai)
#pragma unroll
            for (int m = 0; m < 4; ++m) {
                float s = 0.f;
#pragma unroll
                for (int bj = 0; bj < 2; ++bj)
#pragma unroll
                    for (int n = 0; n < 2; ++n) { const f32x4 x = v[ai][bj][m][n]; s += (x[0] + x[1]) + (x[2] + x[3]); }
                s += __shfl_xor(s, 16); s += __shfl_xor(s, 32);
                const float mw = s * (1.0f / 64.0f); float q = 0.f;
#pragma unroll
                for (int bj = 0; bj < 2; ++bj)
#pragma unroll
                    for (int n = 0; n < 2; ++n) { const f32x4 d = v[ai][bj][m][n] - mw; q += (d[0] * d[0] + d[1] * d[1]) + (d[2] * d[2] + d[3] * d[3]); }
                q += __shfl_xor(q, 16); q += __shfl_xor(q, 32);
                if (fq == 0) P[(ai * HALF + wr * 64 + m * 16 + fr) * 4 + wc] = (f32x2v){mw, q};
            }
        asm volatile("s_waitcnt lgkmcnt(0)" ::: "memory"); __builtin_amdgcn_s_barrier(); asm volatile("" ::: "memory");
#if defined(BROKEN_EXCHANGE_NO_WAIT)
#warning BROKEN CONTROL BUILD: the row-statistics exchange does not wait; results are wrong by design
        if (blockIdx.x >= 64) { const long long t0_ = clock64(); while (clock64() - t0_ < 60000) __builtin_amdgcn_s_sleep(8); }
#endif
        const int row = wid * 32 + (lane & 31);
        if (lane < 32) {
            const f32x2v a = P[row * 4 + 0], b = P[row * 4 + 1], c = P[row * 4 + 2], d = P[row * 4 + 3];
            const float mt = (a.x + b.x + c.x + d.x) * 0.25f;
            const float da = a.x - mt, db = b.x - mt, dc = c.x - mt, dd = d.x - mt;
            const float m2 = (a.y + b.y) + (c.y + d.y) + 64.0f * ((da * da + db * db) + (dc * dc + dd * dd));
            unsigned long long* slot = (unsigned long long*)xbuf + ((size_t)(u.pm * BM + row) * 4 + u.pn);
            __hip_atomic_store(slot, ((unsigned long long)__float_as_uint(m2) << 32) | __float_as_uint(mt), __ATOMIC_RELAXED, __HIP_MEMORY_SCOPE_AGENT);
        }
        asm volatile("s_waitcnt vmcnt(0)" ::: "memory");
        if (lane == 0) __hip_atomic_fetch_add(cnt + 64 * u.pm, 1u, __ATOMIC_RELAXED, __HIP_MEMORY_SCOPE_AGENT);
        if (wid == 0) {
            bool dead = false; const unsigned long long t0 = __builtin_amdgcn_s_memrealtime(); const unsigned want = 8u * (unsigned)ntn;
            for (;;) {
#if defined(BROKEN_EXCHANGE_NO_WAIT)
                break;
#endif
                if ((unsigned)__builtin_amdgcn_readfirstlane(__hip_atomic_load(cnt + 64 * u.pm, __ATOMIC_RELAXED, __HIP_MEMORY_SCOPE_AGENT)) >= want) break;
                if (__builtin_amdgcn_s_memrealtime() - t0 > 2000000ull) {
                    if (lane == 0) { unsigned expect = 0u; __hip_atomic_compare_exchange_strong(tmo + 1, &expect, code | (unsigned)(u.pm & 0xff), __ATOMIC_RELAXED, __ATOMIC_RELAXED, __HIP_MEMORY_SCOPE_AGENT);
                                     __hip_atomic_store(tmo, 1u, __ATOMIC_RELAXED, __HIP_MEMORY_SCOPE_AGENT); }
                    dead = true; break; }
                __builtin_amdgcn_s_sleep(2);
            }
            __builtin_amdgcn_fence(__ATOMIC_ACQUIRE, "agent");
            if (lane == 0) flag[0] = dead ? 1u : 0u;
        }
        asm volatile("s_waitcnt vmcnt(0) lgkmcnt(0)" ::: "memory"); __builtin_amdgcn_s_barrier(); asm volatile("" ::: "memory");
        const bool bad = flag[0] != 0u;
        if (lane < 32) {
            const unsigned long long* slot = (const unsigned long long*)xbuf + (size_t)(u.pm * BM + row) * 4; float mt[4], m2[4]; float ms = 0.f;
#pragma unroll
            for (int t = 0; t < 4; ++t) { if (t < ntn) { const unsigned long long w = __hip_atomic_load(slot + t, __ATOMIC_RELAXED, __HIP_MEMORY_SCOPE_AGENT); mt[t] = __uint_as_float((unsigned)w); m2[t] = __uint_as_float((unsigned)(w >> 32)); } else { mt[t] = 0.f; m2[t] = 0.f; } ms += mt[t]; }
            const float mean = ms / (float)ntn; float q = 0.f;
#pragma unroll
            for (int t = 0; t < 4; ++t) if (t < ntn) { const float dm = mt[t] - mean; q += m2[t] + 256.0f * dm * dm; }
            S[row] = (f32x2v){mean, 1.0f / sqrtf(q / (256.0f * (float)ntn) + eps)};
        }
        asm volatile("s_waitcnt lgkmcnt(0)" ::: "memory"); __builtin_amdgcn_s_barrier(); asm volatile("" ::: "memory");
        return bad;
    }
};

template <class Epi, class Sched, bool ALIGN_EPI = false, bool SP2 = false>
__device__ __forceinline__ void gemm_phase(PG8_LAS unsigned char* lds, const Gemm g, const Sched& S, const Epi& E) {
    const int tid = threadIdx.x, wid = __builtin_amdgcn_readfirstlane(tid >> 6), lane = tid & 63, wr = wid >> 2, wc = wid & 3, fr = lane & 15, fq = lane >> 4;
    const int K = g.K, nt = K / BK;
    unsigned voffA[2], voffB[2];
#pragma unroll
    for (int i = 0; i < 2; ++i) { int R, C; stage_rc(tid * 16 + i * 8192, R, C); const int Rb = Epi::PERM ? ((R & ~31) + perm32(R & 31)) : R;
        voffA[i] = (unsigned)(R * K + C) * 2u; voffB[i] = (unsigned)(Rb * K + C) * 2u; }
    const size_t kstep = (size_t)(BK * 2);
    const size_t hstep = (size_t)HALF * K * 2;
    const size_t tstep = 2 * hstep;
    const unsigned ldsw = (unsigned)wid * 1024u;
    const int aoff = lds_byte(wr * 64 + fr, fq * 8), boff = lds_byte(wc * 32 + fr, fq * 8);
#define PG8_SA(b, h) (((b) * 2 + (h)) * HTB)
#define PG8_SB(b, h) ((4 + (b) * 2 + (h)) * HTB)
#define PG8_STAGE(bufoff, gbase, voff) do { _Pragma("unroll") for (int _i = 0; _i < 2; ++_i) \
        __builtin_amdgcn_global_load_lds((const unsigned*)((const char*)(gbase) + (voff)[_i]), (PG8_LAS unsigned*)(lds + (bufoff) + ldsw + _i * 8192), 16, 0, 0); } while (0)
#define PG8_LDA(dst, b, h) do { _Pragma("unroll") for (int m = 0; m < 4; ++m) _Pragma("unroll") for (int k = 0; k < 2; ++k) dst[m][k] = *(const PG8_LAS bf16x8*)(lds + PG8_SA(b, h) + aoff + m * 2048 + k * 1024); } while (0)
#define PG8_LDB(dst, b, h) do { _Pragma("unroll") for (int n = 0; n < 2; ++n) _Pragma("unroll") for (int k = 0; k < 2; ++k) dst[n][k] = *(const PG8_LAS bf16x8*)(lds + PG8_SB(b, h) + boff + n * 2048 + k * 1024); } while (0)
#define PG8_MMA(ai, bj, At, Bt) do { __builtin_amdgcn_s_setprio(1); _Pragma("unroll") for (int m = 0; m < 4; ++m) _Pragma("unroll") for (int n = 0; n < 2; ++n) _Pragma("unroll") for (int k = 0; k < 2; ++k) \
        acc[ai][bj][m][n] = __builtin_amdgcn_mfma_f32_16x16x32_bf16(Bt[n][k], At[m][k], acc[ai][bj][m][n], 0, 0, 0); __builtin_amdgcn_s_setprio(0); } while (0)
#define PG8_WAIT_V(n) asm volatile("s_waitcnt vmcnt(" #n ")" ::: "memory")
#define PG8_WAIT_L(n) asm volatile("s_waitcnt lgkmcnt(" #n ")" ::: "memory")
#define PG8_BAR __builtin_amdgcn_s_barrier()
#define PG8_SCHED __builtin_amdgcn_sched_barrier(0)
    Unit cur, nxt; int ui = 0;
    if (!S.next(0, cur)) return;
    f32x4 acc[2][2][4][2];
#pragma unroll
    for (int a = 0; a < 2; ++a)
#pragma unroll
        for (int b = 0; b < 2; ++b)
#pragma unroll
            for (int m = 0; m < 4; ++m)
#pragma unroll
                for (int n = 0; n < 2; ++n) acc[a][b][m][n] = (f32x4){0.f, 0.f, 0.f, 0.f};
    bf16x8 At[4][2], B0[2][2], B1[2][2];
    const char* cA = (const char*)g.A + (size_t)cur.pm * tstep; const char* cB = (const char*)g.Bt + (size_t)cur.pn * tstep;
    S.a_ready(cur);
    if constexpr (SP2) {
        PG8_STAGE(PG8_SB(0, 0), cB, voffB); PG8_STAGE(PG8_SB(0, 1), cB + hstep, voffB); PG8_STAGE(PG8_SA(0, 0), cA, voffA); PG8_STAGE(PG8_SA(0, 1), cA + hstep, voffA);
        if (wr == 1) PG8_BAR;
        PG8_WAIT_V(2); PG8_BAR;
        PG8_STAGE(PG8_SB(1, 0), cB + kstep, voffB); PG8_STAGE(PG8_SA(1, 0), cA + kstep, voffA); PG8_STAGE(PG8_SB(1, 1), cB + hstep + kstep, voffB);
        PG8_WAIT_V(6); PG8_BAR;
    } else {
        PG8_STAGE(PG8_SB(0, 0), cB, voffB); PG8_STAGE(PG8_SA(0, 0), cA, voffA); PG8_STAGE(PG8_SB(0, 1), cB + hstep, voffB); PG8_STAGE(PG8_SA(0, 1), cA + hstep, voffA);
        if (wr == 1) PG8_BAR;
        PG8_WAIT_V(4); PG8_BAR;
        PG8_STAGE(PG8_SB(1, 0), cB + kstep, voffB); PG8_STAGE(PG8_SA(1, 0), cA + kstep, voffA); PG8_STAGE(PG8_SB(1, 1), cB + hstep + kstep, voffB);
        PG8_WAIT_V(6); PG8_BAR;
    }
    for (;;) {
        const bool has_next = S.next(ui + 1, nxt);
        const char* nA = has_next ? (const char*)g.A + (size_t)nxt.pm * tstep : cA; const char* nB = has_next ? (const char*)g.Bt + (size_t)nxt.pn * tstep : cB;
        for (int t = 0; t < nt; t += 2) {
            const bool last = (t == nt - 2);
            const char* a1 = cA + (size_t)(t + 1) * kstep;
            const char* a2 = last ? nA : cA + (size_t)(t + 2) * kstep; const char* b2 = last ? nB : cB + (size_t)(t + 2) * kstep;
            const char* a3 = a2 + kstep; const char* b3 = b2 + kstep;
            if (last && has_next) S.a_ready(nxt);
            if constexpr (SP2) {
            PG8_LDB(B0, 0, 0); PG8_LDB(B1, 0, 1); PG8_SCHED; PG8_LDA(At, 0, 0); PG8_STAGE(PG8_SA(1, 1), a1 + hstep, voffA);
            PG8_WAIT_V(8); PG8_WAIT_L(0); PG8_BAR; PG8_MMA(0, 0, At, B0); PG8_MMA(0, 1, At, B1); PG8_BAR; PG8_SCHED;
            PG8_LDA(At, 0, 1); PG8_STAGE(PG8_SB(0, 0), b2, voffB); PG8_STAGE(PG8_SB(0, 1), b2 + hstep, voffB); PG8_STAGE(PG8_SA(0, 0), a2, voffA);
            PG8_WAIT_V(8); PG8_WAIT_L(0); PG8_BAR; PG8_MMA(1, 0, At, B0); PG8_MMA(1, 1, At, B1); PG8_BAR; PG8_SCHED;
            PG8_LDB(B0, 1, 0); PG8_LDB(B1, 1, 1); PG8_SCHED; PG8_LDA(At, 1, 0); PG8_STAGE(PG8_SA(0, 1), a2 + hstep, voffA);
            PG8_WAIT_V(8); PG8_WAIT_L(0); PG8_BAR; PG8_MMA(0, 0, At, B0); PG8_MMA(0, 1, At, B1); PG8_BAR; PG8_SCHED;
            PG8_LDA(At, 1, 1); PG8_STAGE(PG8_SB(1, 0), b3, voffB); PG8_STAGE(PG8_SB(1, 1), b3 + hstep, voffB); PG8_STAGE(PG8_SA(1, 0), a3, voffA);
            PG8_WAIT_V(8); PG8_WAIT_L(0); PG8_BAR; PG8_MMA(1, 0, At, B0); PG8_MMA(1, 1, At, B1); PG8_BAR; PG8_SCHED;
            } else {
            PG8_LDB(B0, 0, 0); PG8_SCHED; PG8_LDA(At, 0, 0); PG8_STAGE(PG8_SA(1, 1), a1 + hstep, voffA);
            PG8_WAIT_L(8); PG8_BAR; PG8_WAIT_L(0); PG8_MMA(0, 0, At, B0); PG8_BAR; PG8_SCHED;
            PG8_LDB(B1, 0, 1); PG8_STAGE(PG8_SB(0, 0), b2, voffB);
            PG8_BAR; PG8_WAIT_L(0); PG8_MMA(0, 1, At, B1); PG8_BAR;
            PG8_LDA(At, 0, 1); PG8_STAGE(PG8_SA(0, 0), a2, voffA);
            PG8_BAR; PG8_WAIT_L(0); PG8_MMA(1, 0, At, B0); PG8_BAR; PG8_SCHED;
            PG8_STAGE(PG8_SB(0, 1), b2 + hstep, voffB);
            PG8_WAIT_V(6); PG8_BAR; PG8_MMA(1, 1, At, B1); PG8_BAR;
            PG8_LDB(B0, 1, 0); PG8_SCHED; PG8_LDA(At, 1, 0); PG8_STAGE(PG8_SA(0, 1), a2 + hstep, voffA);
            PG8_WAIT_L(8); PG8_BAR; PG8_WAIT_L(0); PG8_MMA(0, 0, At, B0); PG8_BAR; PG8_SCHED;
            PG8_LDB(B1, 1, 1); PG8_STAGE(PG8_SB(1, 0), b3, voffB);
            PG8_BAR; PG8_WAIT_L(0); PG8_MMA(0, 1, At, B1); PG8_BAR;
            PG8_LDA(At, 1, 1); PG8_STAGE(PG8_SA(1, 0), a3, voffA);
            PG8_BAR; PG8_WAIT_L(0); PG8_MMA(1, 0, At, B0); PG8_BAR; PG8_SCHED;
            PG8_STAGE(PG8_SB(1, 1), b3 + hstep, voffB);
            PG8_WAIT_V(6); PG8_BAR; PG8_MMA(1, 1, At, B1); PG8_BAR;
            }
        }
        if constexpr (ALIGN_EPI) { if (wr == 0) PG8_BAR; }
        if constexpr (!Epi::AFTER_DRAIN) { E(acc, cur, wr, wc, fr, fq); S.done(cur); }
        if (!has_next) break;
#pragma unroll
        for (int a = 0; a < 2; ++a)
#pragma unroll
            for (int b = 0; b < 2; ++b)
#pragma unroll
                for (int m = 0; m < 4; ++m)
#pragma unroll
                    for (int n = 0; n < 2; ++n) acc[a][b][m][n] = (f32x4){0.f, 0.f, 0.f, 0.f};
        cur = nxt; cA = nA; cB = nB; ++ui;
        if constexpr (ALIGN_EPI) { if (wr == 1) PG8_BAR; }
    }
    PG8_WAIT_V(0);
    if constexpr (!ALIGN_EPI) { if (wr == 0) PG8_BAR; }
    PG8_BAR;
    if constexpr (Epi::AFTER_DRAIN) { E.fused(acc, cur, wr, wc, fr, fq, lds, wid, lane); S.done(cur); }
#undef PG8_SA
#undef PG8_SB
#undef PG8_STAGE
#undef PG8_LDA
#undef PG8_LDB
#undef PG8_MMA
#undef PG8_WAIT_V
#undef PG8_WAIT_L
#undef PG8_BAR
#undef PG8_SCHED
}
}
#define GAS __attribute__((address_space(1)))
#define LAS __attribute__((address_space(3)))
typedef unsigned short bf16;
typedef unsigned v4u __attribute__((ext_vector_type(4)));
typedef float f32x4 __attribute__((ext_vector_type(4)));
typedef short bf16x8 __attribute__((ext_vector_type(8)));
typedef GAS unsigned gu32;
typedef GAS unsigned long long gu64;
#define RLX_AGENT __ATOMIC_RELAXED, __HIP_MEMORY_SCOPE_AGENT
#define LDS_WAIT() asm volatile("s_waitcnt lgkmcnt(0)" ::: "memory")
#define VM_WAIT() asm volatile("s_waitcnt vmcnt(0)" ::: "memory")
__device__ __forceinline__ unsigned long long rt() { return __builtin_amdgcn_s_memrealtime(); }
__device__ __forceinline__ unsigned f2bf(float f) { unsigned u = __builtin_bit_cast(unsigned, f); return (u + 0x7fffu + ((u >> 16) & 1u)) >> 16; }
__device__ __forceinline__ unsigned pk2(float lo, float hi) { return f2bf(lo) | (f2bf(hi) << 16); }

#define XB_TMO      128
#define XB_XCNT(j)  (256  + 64 * (j))
#define XB_XSUB(j)  (1280 + 64 * (j))
#define XB_XGEN(j)  (2304 + 64 * (j))
#define XB_TOP      3328
#define XB_TOPGEN   3392
#define XCD_BAR_WORDS 3456
#define XB_SPIN_CAP (1u << 18)

__device__ __forceinline__ unsigned xb_ld(unsigned* p)              { return __hip_atomic_load(p, __ATOMIC_RELAXED, __HIP_MEMORY_SCOPE_AGENT); }
__device__ __forceinline__ unsigned xb_add(unsigned* p, unsigned v) { return __hip_atomic_fetch_add(p, v, __ATOMIC_RELAXED, __HIP_MEMORY_SCOPE_AGENT); }
__device__ __forceinline__ unsigned xb_xcc_id() { return (unsigned)__builtin_amdgcn_s_getreg((3 << 11) | 20) & 0xFu; }
#define XB_SPIN(cond, bar) do { unsigned _sp = 0; while (cond) { __builtin_amdgcn_s_sleep(1); \
    if ((++_sp & 255u) == 0u) { if (xb_ld(&(bar)[XB_TMO])) break; if (_sp > XB_SPIN_CAP) { atomicAdd(&(bar)[XB_TMO], 1u); break; } } } } while (0)

struct XcdBarrier {
    unsigned* bar; unsigned x;
    volatile LAS unsigned* st;
};

__device__ __forceinline__ XcdBarrier xcd_barrier_post(unsigned* bar, volatile LAS unsigned* st) {
    XcdBarrier b; b.bar = bar; b.x = xb_xcc_id(); b.st = st;
    if (threadIdx.x == 0) { const unsigned tk = xb_add(&bar[XB_XCNT(b.x)], 1u); st[2] = tk; st[3] = b.x; }
    return b;
}
__device__ __forceinline__ void xcd_barrier_complete(unsigned* bar, unsigned x, unsigned& nloc, unsigned& nx) {
    const unsigned G = gridDim.x * gridDim.y * gridDim.z;
    unsigned sum, cnt, mine, sp = 0u;
    for (;;) {
        sum = 0u; cnt = 0u; mine = 0u;
#pragma unroll
        for (unsigned j = 0; j < 16; ++j) { const unsigned c = xb_ld(&bar[XB_XCNT(j)]); sum += c; cnt += (c > 0u) ? 1u : 0u; mine = (j == x) ? c : mine; }
        if (sum == G) break;
        __builtin_amdgcn_s_sleep(1);
        if ((++sp & 255u) == 0u) { if (xb_ld(&bar[XB_TMO])) break; if (sp > XB_SPIN_CAP) { atomicAdd(&bar[XB_TMO], 1u); break; } }
    }
    nloc = mine > 0u ? mine : 1u; nx = cnt > 0u ? cnt : 1u;
}

__device__ __forceinline__ void xcd_barrier(const XcdBarrier& b) {
    asm volatile("s_waitcnt vmcnt(0)" ::: "memory");
    __syncthreads();
    if (threadIdx.x == 0) {
        unsigned* bar = b.bar;
        __builtin_amdgcn_s_waitcnt(0);
        unsigned nloc = b.st[0], nx = b.st[1];
        if (nloc == 0u) { xcd_barrier_complete(bar, b.x, nloc, nx); b.st[0] = nloc; b.st[1] = nx; }
        const unsigned old = xb_add(&bar[XB_XSUB(b.x)], 1u);
        const unsigned gen = old / nloc;
        if (old + 1u == (gen + 1u) * nloc) {
            __builtin_amdgcn_fence(__ATOMIC_RELEASE, "agent");
            asm volatile("s_waitcnt vmcnt(0)" ::: "memory");
            const unsigned og = xb_add(&bar[XB_TOP], 1u);
            const unsigned tg = og / nx;
            if (og + 1u == (tg + 1u) * nx) xb_add(&bar[XB_TOPGEN], 1u);
            else XB_SPIN(xb_ld(&bar[XB_TOPGEN]) == tg, bar);
            __builtin_amdgcn_fence(__ATOMIC_ACQUIRE, "agent");
            xb_add(&bar[XB_XGEN(b.x)], 1u);
            asm volatile("s_waitcnt vmcnt(0)" ::: "memory");
        } else {
            XB_SPIN(xb_ld(&bar[XB_XGEN(b.x)]) == gen, bar);
            __builtin_amdgcn_fence(__ATOMIC_ACQUIRE, "agent");
            asm volatile("s_waitcnt vmcnt(0)" ::: "memory");
        }
    }
    __syncthreads();
}
constexpr int NWAVES = 8, NTHREADS = 512;
constexpr int M = 16384, D = 1024, SEQ = 8192, INW = 2320, N1 = 2560, NE = 256, CAP = 16384;
constexpr float EPS = 1e-6f, LOG2E = 1.4426950408889634f, QS = 0.125f * 1.4426950408889634f;
constexpr size_t MiB = 1u << 20;
constexpr size_t WS_CTL = 0, CTL_ZERO_BYTES = 1 * MiB;
constexpr size_t WS_MOD = 1 * MiB, WS_MODP = 1 * MiB + 64 * 1024  , WS_CS = 2 * MiB, WS_W1T = 4 * MiB, WS_WOT = 10 * MiB, WS_W4T = 12 * MiB, WS_WSDT = 14 * MiB;
constexpr size_t WS_XN = 16 * MiB, WS_GQ = 48 * MiB, WS_GK = 56 * MiB, WS_GV = 64 * MiB, WS_LA = 80 * MiB, WS_SGR = 96 * MiB, WS_SQ = 112 * MiB, WS_SK = 128 * MiB, WS_SV = 132 * MiB;
constexpr size_t WS_OMIX = 136 * MiB, WS_XMID = 168 * MiB, WS_H2 = 232 * MiB, WS_LOGITS = 264 * MiB, WS_SACT = 280 * MiB, WS_SHOUT = 288 * MiB;
constexpr size_t WS_LIST = 352 * MiB, WS_WTS = 368 * MiB, WS_ACT = 370 * MiB  , WS_GST = 460 * MiB, WS_SLOTS = 480 * MiB, WS_XCH = 740 * MiB, WS_NAIVE = 744 * MiB;
constexpr int CW_TMO = 0, CW_CODE = 1, CW_BAR = 4096, CW_SEAM = 16384, SEAM_BANK = 128 * 64, CW_CNT = 49152  ;
constexpr int RING_OFF = 0, RING_BYTES = 131072, LDSCTL_OFF = RING_BYTES, MISC_OFF = LDSCTL_OFF + 320, LDS_BYTES = 147456;

typedef float f32x2_t __attribute__((ext_vector_type(2))); typedef __bf16 bf16x2_t __attribute__((ext_vector_type(2)));
__device__ __forceinline__ unsigned pkbf(float lo, float hi) { f32x2_t v = {lo, hi}; bf16x2_t b = __builtin_convertvector(v, bf16x2_t); return __builtin_bit_cast(unsigned, b); }
__device__ __forceinline__ float bf2f(unsigned short h) { return __uint_as_float((unsigned)h << 16); }
__device__ __forceinline__ f32x4 ld4(const float* p) { return *(const f32x4*)p; }
__device__ __forceinline__ f32x4 ld4(const unsigned short* p) { const unsigned long long w = *(const unsigned long long*)p;
    return (f32x4){__uint_as_float((unsigned)(w & 0xffffu) << 16), __uint_as_float((unsigned)((w >> 16) & 0xffffu) << 16), __uint_as_float((unsigned)((w >> 32) & 0xffffu) << 16), __uint_as_float((unsigned)(w >> 48) << 16)}; }
__device__ __forceinline__ float siluf(float v) { return v / (1.f + __expf(-v)); }
__device__ __forceinline__ float wave_sum(float v) {
#pragma unroll
    for (int o = 1; o < 64; o <<= 1) v += __shfl_xor(v, o);
    return v;
}

struct Frame {
    LAS unsigned char* lds;
    volatile LAS unsigned* MISC;
    gu32* ctl;
    int wave, vcu, G;
    unsigned char* ws;
    __device__ __forceinline__ int lane_id() const { return (int)__builtin_amdgcn_mbcnt_hi(~0u, __builtin_amdgcn_mbcnt_lo(~0u, 0u)); }
    __device__ __forceinline__ int tid_id() const { return wave * 64 + lane_id(); }
    __device__ __forceinline__ int tid_fresh() const { int l; asm volatile("v_mbcnt_lo_u32_b32 %0, -1, 0\n\tv_mbcnt_hi_u32_b32 %0, -1, %0" : "=v"(l)); return wave * 64 + l; }
};
#define FTID (F.tid_id())
#define FLANE (F.lane_id())

__device__ __forceinline__ void tr_writeout(bf16* WT, int K, int dst_row, int k0, LAS float* scr, int lane) {
    LDS_WAIT(); asm volatile("" ::: "memory");
    const int c = lane & 7;
#pragma unroll
    for (int j = 0; j < 4; ++j) { const int n = (lane >> 3) + 8 * j; const LAS float* s = scr + (8 * c) * 33 + n;
        v4u o; o.x = pk2(s[0 * 33], s[1 * 33]); o.y = pk2(s[2 * 33], s[3 * 33]); o.z = pk2(s[4 * 33], s[5 * 33]); o.w = pk2(s[6 * 33], s[7 * 33]);
        *(GAS v4u*)(WT + (size_t)(dst_row + n) * K + k0 + 8 * c) = o; }
    LDS_WAIT(); asm volatile("" ::: "memory");
}
__device__ __forceinline__ void tr_item(const float* W, int ldw, int col0, bf16* WT, int K, int dst_row0, int kb, int nb, LAS float* scr, int lane) {
    const int k0 = 64 * kb, n0 = 32 * nb;
#pragma unroll 8
    for (int i = 0; i < 32; ++i) { const int kk = 2 * i + (lane >> 5); scr[kk * 33 + (lane & 31)] = W[(size_t)(k0 + kk) * ldw + col0 + n0 + (lane & 31)]; }
    tr_writeout(WT, K, dst_row0 + n0, k0, scr, lane);
}
__device__ __forceinline__ void fold_item(const float* w_in, const float* w_up, bf16* WT, int kb, int nb, LAS float* scr, int lane) {
    const int k0 = 64 * kb, n0 = 32 * nb, n = n0 + (lane & 31);
    float wu[16];
#pragma unroll
    for (int r = 0; r < 16; ++r) wu[r] = w_up[r * 256 + n];
    for (int i = 0; i < 32; ++i) { const int kk = 2 * i + (lane >> 5); const float* wi = w_in + (size_t)(k0 + kk) * INW + 1024; float a = 0.f;
#pragma unroll
        for (int r = 0; r < 16; ++r) a += wi[r] * wu[r];
        scr[kk * 33 + (lane & 31)] = a; }
    tr_writeout(WT, 1024, 1024 + n0, k0, scr, lane);
}

struct P0In { const float *c, *w_ada, *b_ada, *w_in, *w_gk_up, *w_out, *w_router, *ws_gate, *ws_up, *ws_down; const int* positions; };
__device__ __forceinline__ void p0a_prep(Frame& F, const P0In& I) {
    bf16* W1t = (bf16*)(F.ws + WS_W1T); bf16* Wot = (bf16*)(F.ws + WS_WOT); bf16* W4t = (bf16*)(F.ws + WS_W4T); bf16* Wsdt = (bf16*)(F.ws + WS_WSDT);
    float* mod = (float*)(F.ws + WS_MOD); float* CS = (float*)(F.ws + WS_CS);
    if (F.vcu < 192) {
        const int cg = F.vcu % 24, slab = F.vcu / 24, lane = FLANE, n0 = 256 * cg + 4 * lane, k0 = 128 * slab + 16 * F.wave;
        f32x4 wv[16];
#pragma unroll
        for (int k = 0; k < 16; ++k) wv[k] = *(const f32x4*)(I.w_ada + (size_t)(k0 + k) * 6144 + n0);
        f32x4 a0 = (f32x4){0.f, 0.f, 0.f, 0.f}, a1 = a0;
#pragma unroll
        for (int k = 0; k < 16; ++k) { a0 = a0 + wv[k] * siluf(I.c[k0 + k]); a1 = a1 + wv[k] * siluf(I.c[1024 + k0 + k]); }
        LAS f32x4* red = (LAS f32x4*)(F.lds + RING_OFF + F.wave * 16384 + 12288);
        red[lane] = a0; red[64 + lane] = a1;
        LDS_WAIT(); __syncthreads();
        if (F.wave < 2) { f32x4 s = (f32x4){0.f, 0.f, 0.f, 0.f};
#pragma unroll
            for (int w = 0; w < 8; ++w) s = s + ((const LAS f32x4*)(F.lds + RING_OFF + w * 16384 + 12288))[64 * F.wave + lane];
            *(f32x4*)((float*)(F.ws + WS_MODP) + (size_t)(slab * 2 + F.wave) * 6144 + n0) = s; }
    }
    LAS float* scr = (LAS float*)(F.lds + RING_OFF + F.wave * 16384);
    const int gw = F.vcu * NWAVES + F.wave, NGW = F.G * NWAVES;
    for (int it = gw; it < 1920; it += NGW) {
        int r = it;
        if (r < 512) { tr_item(I.w_in, INW, 0, W1t, 1024, 0, r / 32, r % 32, scr, FLANE); continue; } r -= 512;
        if (r < 640) { tr_item(I.w_in, INW, 1040, W1t, 1024, 1280, r / 40, r % 40, scr, FLANE); continue; } r -= 640;
        if (r < 128) { fold_item(I.w_in, I.w_gk_up, W1t, r / 8, r % 8, scr, FLANE); continue; } r -= 128;
        if (r < 512) { tr_item(I.w_out, 1024, 0, Wot, 1024, 0, r / 32, r % 32, scr, FLANE); continue; } r -= 512;
        tr_item(I.w_router, 256, 0, W4t, 1024, 0, r / 8, r % 8, scr, FLANE);
    }
    for (int idx = F.vcu * NTHREADS + FTID; idx < M * 8; idx += F.G * NTHREADS) {
        const int row = idx >> 3, i = idx & 7;
        const float inv_freq = powf(500000.0f, -(float)(2 * i) / 16.0f);
        const float ang = (float)I.positions[row] * inv_freq;
        CS[row * 16 + i] = cosf(ang); CS[row * 16 + 8 + i] = sinf(ang);
    }
}

__device__ __forceinline__ void mod_finish(Frame& F, const float* b_ada) {
    const float* P = (const float*)(F.ws + WS_MODP); float* mod = (float*)(F.ws + WS_MOD);
    for (int i = FTID; i < 2 * 6144 / 4; i += NTHREADS) { const int b = i / 1536, n4 = i % 1536;
        f32x4 s = *(const f32x4*)(b_ada + 4 * n4);
#pragma unroll
        for (int sl = 0; sl < 8; ++sl) s = s + *(const f32x4*)(P + (size_t)(sl * 2 + b) * 6144 + 4 * n4);
        *(f32x4*)(mod + b * 6144 + 4 * n4) = s; }
    VM_WAIT(); __syncthreads();
}

template <class T>
__device__ __forceinline__ void norm_rows(Frame& F, const T* x, const float* g, int sh_off, int sc_off, bf16* XN) {
    const float* mod = (const float*)(F.ws + WS_MOD);
    const int gw = F.vcu * NWAVES + F.wave, NGW = F.G * NWAVES, lane = FLANE;
    for (int m = gw; m < M; m += NGW) {
        f32x4 v[4]; float s = 0.f;
#pragma unroll
        for (int j = 0; j < 4; ++j) { v[j] = ld4(x + (size_t)m * D + 4 * lane + 256 * j); s += (v[j].x * v[j].x + v[j].y * v[j].y) + (v[j].z * v[j].z + v[j].w * v[j].w); }
        const float r = rsqrtf(wave_sum(s) * (1.f / D) + EPS);
        const float* mb = mod + (m >> 13) * 6144;
        GAS unsigned long long* o8 = (GAS unsigned long long*)(XN + (size_t)m * D) + lane;
#pragma unroll
        for (int j = 0; j < 4; ++j) { const int c = 4 * lane + 256 * j;
            const f32x4 gg = *(const f32x4*)(g + c), sc = *(const f32x4*)(mb + sc_off + c), sh = *(const f32x4*)(mb + sh_off + c);
            const f32x4 o = v[j] * r * gg * (sc + 1.0f) + sh;
            o8[64 * j] = (unsigned long long)pk2(o.x, o.y) | ((unsigned long long)pk2(o.z, o.w) << 32); }
    }
}

struct EpiP1 {
    static constexpr bool PERM = true, AFTER_DRAIN = false;
    unsigned char* ws; const float* b_gk;
    __device__ __forceinline__ void operator()(const pg8::f32x4 (&acc)[2][2][4][2], const pg8::Unit& u, int wr, int wc, int fr, int fq) const {
        const int row0 = u.pm * 256 + wr * 64 + fr, cl0 = wc * 32 + 8 * fq, pn = u.pn;
        if (pn == 4) {
            float* LA = (float*)(ws + WS_LA);
#pragma unroll
            for (int bj = 0; bj < 2; ++bj) {
                const int col = bj * 128 + cl0;
                const f32x4 b0 = *(const f32x4*)(b_gk + col), b1 = *(const f32x4*)(b_gk + col + 4);
#pragma unroll
                for (int ai = 0; ai < 2; ++ai)
#pragma unroll
                    for (int m = 0; m < 4; ++m) {
                        const f32x4 z0 = acc[ai][bj][m][0] + b0, z1 = acc[ai][bj][m][1] + b1; f32x4 o0, o1;
#pragma unroll
                        for (int i = 0; i < 4; ++i) { o0[i] = (fminf(z0[i], 0.f) - __logf(1.f + __expf(-fabsf(z0[i])))) * 0.0625f; o1[i] = (fminf(z1[i], 0.f) - __logf(1.f + __expf(-fabsf(z1[i])))) * 0.0625f; }
                        float* dst = LA + (size_t)(row0 + ai * 128 + m * 16) * 256 + col;
                        *(f32x4*)dst = o0; *(f32x4*)(dst + 4) = o1;
                    }
            }
            return;
        }
        size_t boff; int ld, bjs = 128, mode = 0; float scale = 1.f;
        if (pn == 0) { boff = WS_GQ; ld = 256; scale = 0.125f; }
        else if (pn == 1) { boff = WS_GK; ld = 256; }
        else if (pn < 4) { boff = WS_GV + (size_t)(pn - 2) * 512; ld = 512; }
        else if (pn < 7) { boff = WS_SGR + (size_t)(pn - 5) * 512; ld = 512; mode = 1; }
        else if (pn < 9) { boff = WS_SQ + (size_t)(pn - 7) * 512; ld = 512; mode = 2; scale = QS; }
        else { boff = WS_SK; ld = 128; bjs = (int)((WS_SV - WS_SK) / 2); mode = 3; }
        bf16* base = (bf16*)(ws + boff) + cl0;
        const bool ropewave = (mode >= 2) && ((wc & 1) == 0);
        const float* CS = (const float*)(ws + WS_CS);
#pragma unroll
        for (int ai = 0; ai < 2; ++ai)
#pragma unroll
            for (int m = 0; m < 4; ++m) {
                const int row = row0 + ai * 128 + m * 16;
                f32x4 cs0, cs1, sn0, sn1;
                if (ropewave) { const f32x4* cp = (const f32x4*)(CS + (size_t)row * 16); cs0 = cp[0]; cs1 = cp[1]; sn0 = cp[2]; sn1 = cp[3]; }
#pragma unroll
                for (int bj = 0; bj < 2; ++bj) {
                    f32x4 v0 = acc[ai][bj][m][0], v1 = acc[ai][bj][m][1];
                    if (mode == 1) {
#pragma unroll
                        for (int i = 0; i < 4; ++i) { v0[i] = siluf(v0[i]); v1[i] = siluf(v1[i]); }
                    }
                    if (ropewave && (mode == 2 || bj == 0)) {
                        f32x4 p0, p1;
#pragma unroll
                        for (int i = 0; i < 4; ++i) { p0[i] = __shfl_xor(v0[i], 16); p1[i] = __shfl_xor(v1[i], 16); }
                        if (fq == 0) { v0 = v0 * cs0 - p0 * sn0; v1 = v1 * cs1 - p1 * sn1; }
                        else if (fq == 1) { v0 = v0 * cs0 + p0 * sn0; v1 = v1 * cs1 + p1 * sn1; }
                    }
                    v0 = v0 * scale; v1 = v1 * scale;
                    pg8::u32x4 w; w.x = pg8::cvt_pk_bf16(v0[0], v0[1]); w.y = pg8::cvt_pk_bf16(v0[2], v0[3]); w.z = pg8::cvt_pk_bf16(v1[0], v1[1]); w.w = pg8::cvt_pk_bf16(v1[2], v1[3]);
                    *(pg8::u32x4*)(base + (size_t)row * ld + bj * bjs) = w;
                }
            }
    }
};
struct EpiXmid {
    static constexpr bool PERM = true, AFTER_DRAIN = false;
    const float* x; const float* mod; bf16* xmid;
    __device__ __forceinline__ void operator()(const pg8::f32x4 (&acc)[2][2][4][2], const pg8::Unit& u, int wr, int wc, int fr, int fq) const {
        const int row0 = u.pm * 256 + wr * 64 + fr, col0 = u.pn * 256 + wc * 32 + 8 * fq;
        const float* gt = mod + (u.pm >> 5) * 6144 + 2048;
        pg8::f32x4 gv[2][2];
#pragma unroll
        for (int bj = 0; bj < 2; ++bj)
#pragma unroll
            for (int n = 0; n < 2; ++n) gv[bj][n] = *(const pg8::f32x4*)(gt + col0 + bj * 128 + n * 4);
#pragma unroll
        for (int ai = 0; ai < 2; ++ai)
#pragma unroll
            for (int m = 0; m < 4; ++m) { const size_t off = (size_t)(row0 + ai * 128 + m * 16) * D + col0;
#pragma unroll
                for (int bj = 0; bj < 2; ++bj) {
                    const pg8::f32x4 v0 = *(const pg8::f32x4*)(x + off + bj * 128) + gv[bj][0] * acc[ai][bj][m][0], v1 = *(const pg8::f32x4*)(x + off + bj * 128 + 4) + gv[bj][1] * acc[ai][bj][m][1];
                    pg8::u32x4 w; w.x = pg8::cvt_pk_bf16(v0[0], v0[1]); w.y = pg8::cvt_pk_bf16(v0[2], v0[3]); w.z = pg8::cvt_pk_bf16(v1[0], v1[1]); w.w = pg8::cvt_pk_bf16(v1[2], v1[3]);
                    *(pg8::u32x4*)(xmid + off + bj * 128) = w; } }
    }
};
struct EpiP4 {
    static constexpr bool PERM = true, AFTER_DRAIN = false;
    float* logits;
    __device__ __forceinline__ void operator()(const pg8::f32x4 (&acc)[2][2][4][2], const pg8::Unit& u, int wr, int wc, int fr, int fq) const {
        const int row0 = u.pm * 256 + wr * 64 + fr, cl0 = wc * 32 + 8 * fq;
#pragma unroll
        for (int ai = 0; ai < 2; ++ai)
#pragma unroll
            for (int m = 0; m < 4; ++m) { const int row = row0 + ai * 128 + m * 16;
#pragma unroll
                for (int bj = 0; bj < 2; ++bj) { float* dst = logits + (size_t)row * 256 + bj * 128 + cl0; *(pg8::f32x4*)dst = acc[ai][bj][m][0]; *(pg8::f32x4*)(dst + 4) = acc[ai][bj][m][1]; } }
    }
};
__device__ __forceinline__ unsigned fkey(float v) { const unsigned b = __float_as_uint(v); return b ^ ((unsigned)((int)b >> 31) | 0x80000000u); }
__device__ __forceinline__ void route_tokens(Frame& F, const float* logits, const float* rbias, int* cnt, int* list, float* wts) {
    typedef unsigned u32x2 __attribute__((ext_vector_type(2)));
    const int gw = F.vcu * NWAVES + F.wave, NGW = F.G * NWAVES, lane = FLANE;
    LAS u32x2* stg = (LAS u32x2*)(F.lds + RING_OFF + F.wave * 1024);
    const f32x4 rb = *(const f32x4*)(rbias + lane * 4);
    const unsigned long long lt = (1ull << lane) - 1ull;
    for (int t0 = gw; t0 < M; t0 += 8 * NGW) {
        for (int j = 0; j < 8; ++j) {
            const int t = t0 + j * NGW;
            if (t >= M) break;
            const f32x4 lg = *(const f32x4*)(logits + (size_t)t * 256 + lane * 4);
            const float sc0 = 1.f / (1.f + expf(-lg.x)), sc1 = 1.f / (1.f + expf(-lg.y)), sc2 = 1.f / (1.f + expf(-lg.z)), sc3 = 1.f / (1.f + expf(-lg.w));
            float s0 = sc0 + rb.x, s1 = sc1 + rb.y, s2 = sc2 + rb.z, s3 = sc3 + rb.w;
            float m1 = fmaxf(s0, s1), m2 = fminf(s0, s1);
            { const float n1 = fmaxf(m1, s2), n2 = fmaxf(fminf(m1, s2), m2); m1 = n1; m2 = n2; }
            { const float n1 = fmaxf(m1, s3), n2 = fmaxf(fminf(m1, s3), m2); m1 = n1; m2 = n2; }
#pragma unroll
            for (int off = 1; off < 8; off <<= 1) {
                const float o1 = __shfl_xor(m1, off), o2 = __shfl_xor(m2, off);
                const float n1 = fmaxf(m1, o1), n2 = fmaxf(fminf(m1, o1), fmaxf(m2, o2)); m1 = n1; m2 = n2;
            }
            const float gs = m1 + m2; const int myg = lane >> 3;
            int rank = 0;
#pragma unroll
            for (int g = 0; g < 8; ++g) { const float gj = __uint_as_float((unsigned)__builtin_amdgcn_readlane((int)__float_as_uint(gs), g * 8)); rank += (gj > gs || (gj == gs && g < myg)) ? 1 : 0; }
            if (rank >= 4) { s0 = -INFINITY; s1 = -INFINITY; s2 = -INFINITY; s3 = -INFINITY; }
            const unsigned k0 = fkey(s0), k1 = fkey(s1), k2 = fkey(s2), k3 = fkey(s3);
            unsigned T = 0u;
#pragma unroll 4
            for (int bit = 31; bit >= 0; --bit) {
                const unsigned cand = T | (1u << bit);
                const int c = __popcll(__ballot(k0 >= cand)) + __popcll(__ballot(k1 >= cand)) + __popcll(__ballot(k2 >= cand)) + __popcll(__ballot(k3 >= cand));
                if (c >= 8) T = cand;
            }
            const bool g0 = k0 > T, g1 = k1 > T, g2 = k2 > T, g3 = k3 > T, e0 = k0 == T, e1 = k1 == T, e2 = k2 == T, e3 = k3 == T;
            const int need = 8 - (__popcll(__ballot(g0)) + __popcll(__ballot(g1)) + __popcll(__ballot(g2)) + __popcll(__ballot(g3)));
            const int eb = __popcll(__ballot(e0) & lt) + __popcll(__ballot(e1) & lt) + __popcll(__ballot(e2) & lt) + __popcll(__ballot(e3) & lt);
            const int r1 = eb + (e0 ? 1 : 0), r2 = r1 + (e1 ? 1 : 0), r3 = r2 + (e2 ? 1 : 0);
            const bool p0 = g0 || (e0 && eb < need), p1 = g1 || (e1 && r1 < need), p2 = g2 || (e2 && r2 < need), p3 = g3 || (e3 && r3 < need);
            const int qb = __popcll(__ballot(p0) & lt) + __popcll(__ballot(p1) & lt) + __popcll(__ballot(p2) & lt) + __popcll(__ballot(p3) & lt);
            const int q1 = qb + (p0 ? 1 : 0), q2 = q1 + (p1 ? 1 : 0), q3 = q2 + (p2 ? 1 : 0);
            const float wsum = wave_sum((p0 ? sc0 : 0.f) + (p1 ? sc1 : 0.f) + (p2 ? sc2 : 0.f) + (p3 ? sc3 : 0.f));
            const float ws = 2.5f / wsum;
            if (p0) stg[j * 8 + qb] = (u32x2){(unsigned)(lane * 4 + 0), __float_as_uint(sc0 / wsum * 2.5f)};
            if (p1) stg[j * 8 + q1] = (u32x2){(unsigned)(lane * 4 + 1), __float_as_uint(sc1 / wsum * 2.5f)};
            if (p2) stg[j * 8 + q2] = (u32x2){(unsigned)(lane * 4 + 2), __float_as_uint(sc2 / wsum * 2.5f)};
            if (p3) stg[j * 8 + q3] = (u32x2){(unsigned)(lane * 4 + 3), __float_as_uint(sc3 / wsum * 2.5f)};
            (void)ws;
        }
        LDS_WAIT(); asm volatile("" ::: "memory");
        const int my_t = t0 + (lane >> 3) * NGW;
        if (my_t < M) {
            const u32x2 ent = stg[lane];
            const int my_e = (int)ent.x;
            const int pos = atomicAdd(&cnt[my_e * 64], 1);
            list[my_e * CAP + pos] = my_t * 8 + (lane & 7);
            wts[my_t * 8 + (lane & 7)] = __uint_as_float(ent.y);
        }
        LDS_WAIT(); asm volatile("" ::: "memory");
    }
}
namespace moe {
constexpr int A_BYTES = 256 * 64, B_KG = 2240, B_BYTES = 8 * B_KG;
constexpr int OFF_A = 0, OFF_B = 2 * A_BYTES, OFF_ROW = OFF_B + 2 * B_BYTES, OFF_MAP = OFF_ROW + 2048, LDS_END = OFF_MAP + 3 * 260 * 4;
static_assert(LDS_END <= RING_BYTES, "moe LDS");
typedef short bf16x8 __attribute__((ext_vector_type(8)));
typedef short s16x4 __attribute__((ext_vector_type(4)));
typedef unsigned u32x2 __attribute__((ext_vector_type(2)));

struct Ctx { const bf16* H2; const float *wg, *wu, *wd; const int* list; const float* wts; bf16* ACT; bf16* SLOT; const float *sg, *su, *sd; bf16* SHOUT; };

__device__ __forceinline__ void unit(Frame& F, const Ctx& C, int e, int mt, int cnt_e, int pos0, bool shared) {
    LAS unsigned char* L = F.lds + RING_OFF;
    LAS int* rowent = (LAS int*)(L + OFF_ROW); LAS float* roww = (LAS float*)(L + OFF_ROW + 1024);
    const int tid = F.tid_fresh();
    const int lane = tid & 63, wid = F.wave, wr = wid >> 2, wc = wid & 3, fr = lane & 15, fq = lane >> 4;
    const int mvalid = min(256, cnt_e - mt * 256);
    const int tsh = shared ? 0 : 3;
    if (tid < 256) { int ent = -1; float wv = 0.f;
        if (tid < mvalid) { if (shared) { ent = mt * 256 + tid; wv = 1.f; } else { ent = C.list[(size_t)e * CAP + mt * 256 + tid]; wv = C.wts[ent]; } }
        rowent[tid] = ent; roww[tid] = wv; }
    LDS_WAIT(); __syncthreads();
    const int ar0 = tid >> 2, ac = tid & 3;
    if (tid < 256 && tid >= mvalid) rowent[tid] = -1 - rowent[0];
    LDS_WAIT(); __syncthreads();
    const unsigned aw_off0 = (unsigned)(ar0 * 64 + ((ac ^ ((0 - (ar0 >> 2)) & 3)) * 16));
    const int hb = lane >> 5, l5 = lane & 31;
    const unsigned bw_off = (unsigned)(wid * B_KG + (32 * hb + 8 * (l5 >> 3) + 4 * (l5 & 1) + ((l5 >> 1) & 3)) * 8);
    const unsigned ar_off = (unsigned)((64 * wr + fr) * 64 + ((fq ^ ((0 - (fr >> 2)) & 3)) * 16));
    const unsigned br_off = (unsigned)(2 * fq * B_KG + (fr & 3) * 544 + (8 * wc + (fr >> 2)) * 8);

    const float *wg_ = shared ? C.sg : C.wg, *wu_ = shared ? C.su : C.wu, *wd_ = shared ? C.sd : C.wd; bf16* const outb = shared ? C.SHOUT : C.SLOT; asm volatile("" : "+s"(wg_), "+s"(wu_), "+s"(wd_));
    const float* bbase1 = (hb ? wu_ : wg_) + (size_t)e * D * 256 + 4 * l5 + (size_t)(4 * wid) * 256;
    const float* bbase2 = wd_ + (size_t)e * 256 * D + hb * 128 + 4 * l5 + (size_t)(4 * wid) * D;
    const bf16* act0 = C.ACT + (size_t)pos0 * 256;
    f32x4 acc[2][2][4][2];
#define MOE_ZERO() do { _Pragma("unroll") for (int a_ = 0; a_ < 2; ++a_) _Pragma("unroll") for (int b_ = 0; b_ < 2; ++b_) _Pragma("unroll") for (int m_ = 0; m_ < 4; ++m_) \
        _Pragma("unroll") for (int n_ = 0; n_ < 2; ++n_) acc[a_][b_][m_][n_] = (f32x4){0.f, 0.f, 0.f, 0.f}; } while (0)
    v4u ra0[2]; f32x4 rb0[4], rb1[4];
#define MOE_LOADB(RB, x) do { const int x_ = (x); const float* p_; int ld_; \
        if (x_ < 64) { p_ = bbase1 + (x_ >> 5) * 128 + (size_t)((x_ & 31) * 32) * 256; ld_ = 256; } \
        else { const int y_ = x_ - 64; p_ = bbase2 + (y_ >> 3) * 256 + (size_t)((y_ & 7) * 32) * D; ld_ = D; } \
        _Pragma("unroll") for (int kk = 0; kk < 4; ++kk) RB[kk] = *(const f32x4*)(p_ + (size_t)kk * ld_); } while (0)
#define MOE_LOADA(RA, x) do { const int x_ = (x); \
        if (x_ < 64) { const int e0_ = rowent[ar0], e1_ = rowent[ar0 + 128]; const unsigned t0_ = (unsigned)((e0_ < 0 ? -1 - e0_ : e0_) >> tsh), t1_ = (unsigned)((e1_ < 0 ? -1 - e1_ : e1_) >> tsh); \
            RA[0] = *(const v4u*)(C.H2 + (size_t)t0_ * D + ac * 8 + (x_ & 31) * 32); RA[1] = *(const v4u*)(C.H2 + (size_t)t1_ * D + ac * 8 + (x_ & 31) * 32); } \
        else { RA[0] = *(const v4u*)(act0 + min(ar0, mvalid - 1) * 256 + ac * 8 + (x_ & 7) * 32); RA[1] = *(const v4u*)(act0 + min(ar0 + 128, mvalid - 1) * 256 + ac * 8 + (x_ & 7) * 32); } } while (0)
#define MOE_WRITE(buf, RA, RB) do { LAS unsigned char* Ab = L + OFF_A + (buf) * A_BYTES; LAS unsigned char* Bb = L + OFF_B + (buf) * B_BYTES; \
        *(LAS v4u*)(Ab + aw_off0) = RA[0]; *(LAS v4u*)(Ab + aw_off0 + 8192) = RA[1]; \
        _Pragma("unroll") for (int i = 0; i < 4; ++i) { u32x2 w_; w_.x = pkbf(RB[0][i], RB[1][i]); w_.y = pkbf(RB[2][i], RB[3][i]); *(LAS u32x2*)(Bb + bw_off + i * 544) = w_; } } while (0)
#define MOE_COMPUTE(xc) do { const int bsel_ = (xc) & 1; \
        const LAS unsigned char* Ab = L + OFF_A + bsel_ * A_BYTES + ar_off; const LAS unsigned char* Bb = L + OFF_B + bsel_ * B_BYTES + br_off; \
        bf16x8 bf[2][2]; \
        _Pragma("unroll") for (int bj = 0; bj < 2; ++bj) _Pragma("unroll") for (int n = 0; n < 2; ++n) { \
            const u32x2 lo = *(const LAS u32x2*)(Bb + bj * 256 + n * 32), hi = *(const LAS u32x2*)(Bb + bj * 256 + n * 32 + B_KG); \
            bf[bj][n] = __builtin_bit_cast(bf16x8, (v4u){lo.x, lo.y, hi.x, hi.y}); } \
        _Pragma("unroll") for (int ai = 0; ai < 2; ++ai) { bf16x8 af[4]; if (ai) __builtin_amdgcn_sched_barrier(0); \
            _Pragma("unroll") for (int m = 0; m < 4; ++m) af[m] = *(const LAS bf16x8*)(Ab + (128 * ai + 16 * m) * 64); \
            _Pragma("unroll") for (int m = 0; m < 4; ++m) _Pragma("unroll") for (int bj = 0; bj < 2; ++bj) _Pragma("unroll") for (int n = 0; n < 2; ++n) \
                acc[ai][bj][m][n] = __builtin_amdgcn_mfma_f32_16x16x32_bf16(bf[bj][n], af[m], acc[ai][bj][m][n], 0, 0, 0); } } while (0)
    const int cl0 = 32 * wc + 8 * fq;
#define MOE_EPILOGUE(pass) do { const int ps_ = (pass); \
        _Pragma("unroll") for (int ai = 0; ai < 2; ++ai) _Pragma("unroll") for (int m = 0; m < 4; ++m) { \
            const int r = 128 * ai + 64 * wr + 16 * m + fr; \
            if (r < mvalid) { \
                if (ps_ < 2) { \
                    f32x4 a0 = acc[ai][0][m][0], a1 = acc[ai][0][m][1]; const f32x4 u0 = acc[ai][1][m][0], u1 = acc[ai][1][m][1]; \
                    _Pragma("unroll") for (int i = 0; i < 4; ++i) { a0[i] = siluf(a0[i]) * u0[i]; a1[i] = siluf(a1[i]) * u1[i]; } \
                    v4u w_; w_.x = pkbf(a0[0], a0[1]); w_.y = pkbf(a0[2], a0[3]); w_.z = pkbf(a1[0], a1[1]); w_.w = pkbf(a1[2], a1[3]); \
                    *(v4u*)(C.ACT + (size_t)(pos0 + r) * 256 + ps_ * 128 + cl0) = w_; \
                } else { \
                    const float wgt = roww[r]; bf16* dst = outb + (size_t)rowent[r] * D + (ps_ - 2) * 256 + cl0; \
                    _Pragma("unroll") for (int bj = 0; bj < 2; ++bj) { const f32x4 a0 = acc[ai][bj][m][0] * wgt, a1 = acc[ai][bj][m][1] * wgt; \
                        v4u w_; w_.x = pkbf(a0[0], a0[1]); w_.y = pkbf(a0[2], a0[3]); w_.z = pkbf(a1[0], a1[1]); w_.w = pkbf(a1[2], a1[3]); \
                        *(v4u*)(dst + bj * 128) = w_; } \
                } } } \
        MOE_ZERO(); } while (0)
#define MOE_STEP(x, RBL, RBW) do { const int xs_ = (x); \
        if (xs_ + 1 < 96 && xs_ + 1 != 64) MOE_LOADA(ra0, xs_ + 1); \
        if (xs_ + 2 < 96) MOE_LOADB(RBL, xs_ + 2); \
        MOE_COMPUTE(xs_); \
        if (xs_ == 31 || xs_ == 63 || (xs_ >= 71 && ((xs_ - 63) & 7) == 0)) { \
            const int ps_e = xs_ < 64 ? (xs_ >> 5) : 2 + ((xs_ - 64) >> 3); \
            MOE_EPILOGUE(ps_e); \
            if (xs_ == 63) { VM_WAIT(); __syncthreads(); MOE_LOADA(ra0, 64); } } \
        if (xs_ + 1 < 96) MOE_WRITE((xs_ + 1) & 1, ra0, RBW); \
        LDS_WAIT(); __syncthreads(); } while (0)
    MOE_LOADA(ra0, 0); MOE_LOADB(rb0, 0); MOE_LOADB(rb1, 1);
    MOE_WRITE(0, ra0, rb0);
    LDS_WAIT(); __syncthreads();
    MOE_ZERO();
    for (int x = 0; x < 96; x += 2) {
        MOE_STEP(x, rb0, rb1);
        MOE_STEP(x + 1, rb1, rb0);
    }
#undef MOE_ZERO
#undef MOE_LOADB
#undef MOE_LOADA
#undef MOE_WRITE
#undef MOE_COMPUTE
#undef MOE_EPILOGUE
#undef MOE_STEP
    __syncthreads();
}

__device__ __forceinline__ void phase(Frame& F, const Ctx& C, const int* cnt_g) {
    LAS unsigned char* L = F.lds + RING_OFF;
    LAS int* cnt = (LAS int*)(L + OFF_MAP); LAS int* offs = cnt + 260; LAS int* toff = offs + 260;
    if (FTID < NE) cnt[FTID] = cnt_g[FTID * 64];
    LDS_WAIT(); __syncthreads();
    if (FTID == 0) { int a = 0, b = 0; for (int e = 0; e < NE; ++e) { offs[e] = a; toff[e] = b; a += cnt[e]; b += (cnt[e] + 255) >> 8; } offs[NE] = a; toff[NE] = b; }
    LDS_WAIT(); __syncthreads();
    const int nunits = __builtin_amdgcn_readfirstlane(toff[NE]);
    int vcu = F.vcu;
    { const unsigned* bw = (const unsigned*)(F.ctl + CW_BAR); bool ok = (F.G % 8) == 0;
      for (int j = 0; j < 8; ++j) ok = ok && (__hip_atomic_load(bw + XB_XCNT(j), __ATOMIC_RELAXED, __HIP_MEMORY_SCOPE_AGENT) == (unsigned)(F.G / 8));
      const unsigned rk = F.MISC[10], xc = F.MISC[11];
      if (ok && xc < 8u && rk < (unsigned)(F.G / 8)) vcu = (int)(xc * (unsigned)(F.G / 8) + rk);
      vcu = __builtin_amdgcn_readfirstlane(vcu); }
    for (int u = vcu; u < nunits + M / 256; u += F.G) {
        const bool shared = u >= nunits;
        int e = 0, mt = u - nunits, ce = M, p0 = M * 8 + mt * 256;
        if (!shared) { int lo = 0, hi = NE;
            while (hi - lo > 1) { const int mid = (lo + hi) >> 1; if (toff[mid] <= u) lo = mid; else hi = mid; }
            e = lo; mt = u - toff[lo]; ce = cnt[e]; p0 = offs[e] + mt * 256; }
        unit(F, C, e, mt, ce, p0, shared);
    }
}
}

__device__ __forceinline__ void final_rows_slots(Frame& F, const bf16* xmid, const bf16* shout, const bf16* SLOT, const float* g, float* out) {
    const float* mod = (const float*)(F.ws + WS_MOD);
    const int gw = F.vcu * NWAVES + F.wave, NGW = F.G * NWAVES;
    for (int m = gw; m < M; m += NGW) {
        const size_t ro = (size_t)m * D;
        const float* gt = mod + (m >> 13) * 6144 + 5120;
        f32x4 v[4]; float s = 0.f;
#pragma unroll
        for (int j = 0; j < 4; ++j) { const int c = 4 * FLANE + 256 * j;
            f32x4 acc = ld4(shout + ro + c);
#pragma unroll
            for (int k = 0; k < 8; ++k) acc = acc + ld4(SLOT + ((size_t)m * 8 + k) * D + c);
            const f32x4 xv = ld4(xmid + ro + c), gg = *(const f32x4*)(gt + c);
            v[j] = xv + gg * acc; s += (v[j].x * v[j].x + v[j].y * v[j].y) + (v[j].z * v[j].z + v[j].w * v[j].w); }
        const float r = rsqrtf(wave_sum(s) * (1.f / D) + EPS);
#pragma unroll
        for (int j = 0; j < 4; ++j) { const int c = 4 * FLANE + 256 * j; const f32x4 gf = *(const f32x4*)(g + c); *(f32x4*)(out + ro + c) = v[j] * r * gf; }
    }
}
namespace gla {
typedef short bf16x8 __attribute__((ext_vector_type(8)));
typedef short s16x4 __attribute__((ext_vector_type(4)));
typedef unsigned u32x2 __attribute__((ext_vector_type(2)));
constexpr int LDW = 144;
constexpr int OFF_Q2 = 0, OFF_QI = 9216, OFF_KI = 18432, OFF_K2T = 27648, OFF_VT = 36864, OFF_ST = 55296, OFF_T = 73728, OFF_DEC = 75776, OFF_SS = 76032, LDS_END = 76544;
struct Ctx { const bf16 *GQ, *GK, *GV, *SGR; const float* LA; const float* g_out; float* GST; float* GDEC; bf16* OMIX; };

template <bool FULL>
__device__ __forceinline__ void chunk(Frame& F, const Ctx& C, int b, int h, size_t row0, f32x4 (&S)[4], float& sumtot) {
    LAS unsigned char* L = F.lds + RING_OFF;
    const int tid = FTID, lane = FLANE, w = F.wave, fr = lane & 15, fq = lane >> 4;
    const int d = tid & 63, g = w, dvv = tid & 127, jg = tid >> 7;
    float la[8], kk[8], qq[8]; unsigned short vv[16];
#pragma unroll
    for (int jj = 0; jj < 8; ++jj) { const size_t r = row0 + 8 * g + jj;
        la[jj] = C.LA[r * 256 + h * 64 + d]; kk[jj] = bf2f(C.GK[r * 256 + h * 64 + d]);
        if (FULL) qq[jj] = bf2f(C.GQ[r * 256 + h * 64 + d]); }
#pragma unroll
    for (int jj = 0; jj < 16; ++jj) vv[jj] = C.GV[(row0 + 16 * jg + jj) * 512 + h * 128 + dvv];
#pragma unroll
    for (int jj = 1; jj < 8; ++jj) la[jj] += la[jj - 1];
    LAS float* T = (LAS float*)(L + OFF_T);
    T[g * 64 + d] = la[7];
    LDS_WAIT(); __syncthreads();
    float P = 0.f, tot = 0.f, bref = 0.f;
#pragma unroll
    for (int gg = 0; gg < 8; ++gg) { const float t = T[gg * 64 + d]; if (gg < g) P += t; if (gg < 4) bref += t; tot += t; }
    sumtot += tot;
    {
        unsigned k2w[4];
#pragma unroll
        for (int jj = 0; jj < 8; jj += 2) {
            const float b0 = P + la[jj], b1 = P + la[jj + 1];
            k2w[jj >> 1] = pk2(kk[jj] * __expf(tot - b0), kk[jj + 1] * __expf(tot - b1));
            if (FULL) {
                const int j0 = 8 * g + jj;
                *(LAS unsigned short*)(L + OFF_Q2 + j0 * LDW + d * 2) = (unsigned short)f2bf(qq[jj] * __expf(b0));
                *(LAS unsigned short*)(L + OFF_Q2 + (j0 + 1) * LDW + d * 2) = (unsigned short)f2bf(qq[jj + 1] * __expf(b1));
                *(LAS unsigned short*)(L + OFF_QI + j0 * LDW + d * 2) = (unsigned short)f2bf(qq[jj] * __expf(b0 - bref));
                *(LAS unsigned short*)(L + OFF_QI + (j0 + 1) * LDW + d * 2) = (unsigned short)f2bf(qq[jj + 1] * __expf(b1 - bref));
                *(LAS unsigned short*)(L + OFF_KI + j0 * LDW + d * 2) = (unsigned short)f2bf(kk[jj] * __expf(bref - b0));
                *(LAS unsigned short*)(L + OFF_KI + (j0 + 1) * LDW + d * 2) = (unsigned short)f2bf(kk[jj + 1] * __expf(bref - b1));
            }
        }
        *(LAS v4u*)(L + OFF_K2T + d * LDW + 16 * g) = (v4u){k2w[0], k2w[1], k2w[2], k2w[3]};
        if (g == 0) ((LAS float*)(L + OFF_DEC))[d] = __expf(tot);
        v4u v0, v1;
        v0.x = vv[0] | ((unsigned)vv[1] << 16); v0.y = vv[2] | ((unsigned)vv[3] << 16); v0.z = vv[4] | ((unsigned)vv[5] << 16); v0.w = vv[6] | ((unsigned)vv[7] << 16);
        v1.x = vv[8] | ((unsigned)vv[9] << 16); v1.y = vv[10] | ((unsigned)vv[11] << 16); v1.z = vv[12] | ((unsigned)vv[13] << 16); v1.w = vv[14] | ((unsigned)vv[15] << 16);
        *(LAS v4u*)(L + OFF_VT + dvv * LDW + 32 * jg) = v0; *(LAS v4u*)(L + OFF_VT + dvv * LDW + 32 * jg + 16) = v1;
        if (FULL) {
#pragma unroll
            for (int nt = 0; nt < 4; ++nt) { u32x2 sw; sw.x = pk2(S[nt][0], S[nt][1]); sw.y = pk2(S[nt][2], S[nt][3]);
                *(LAS u32x2*)(L + OFF_ST + (16 * w + fr) * LDW + (16 * nt + 4 * fq) * 2) = sw; }
        }
    }
    LDS_WAIT(); __syncthreads();
    const int it = w >> 1, dvh = w & 1;
    f32x4 dO[4];
    if (FULL) {
        f32x4 dp[4];
#pragma unroll
        for (int nt = 0; nt < 4; ++nt) dp[nt] = (f32x4){0.f, 0.f, 0.f, 0.f};
#pragma unroll
        for (int ks = 0; ks < 2; ++ks) {
            const bf16x8 yq = *(const LAS bf16x8*)(L + OFF_QI + (16 * it + fr) * LDW + (32 * ks + 8 * fq) * 2);
#pragma unroll
            for (int nt = 0; nt < 4; ++nt) { const bf16x8 xk = *(const LAS bf16x8*)(L + OFF_KI + (16 * nt + fr) * LDW + (32 * ks + 8 * fq) * 2);
                dp[nt] = __builtin_amdgcn_mfma_f32_16x16x32_bf16(xk, yq, dp[nt], 0, 0, 0); }
        }
        const int iloc = 16 * it + fr;
#pragma unroll
        for (int nt = 0; nt < 4; ++nt)
#pragma unroll
            for (int r = 0; r < 4; ++r) if (16 * nt + 4 * fq + r > iloc) dp[nt][r] = 0.f;
        bf16x8 yp[2];
#pragma unroll
        for (int ks = 0; ks < 2; ++ks) { v4u pw; pw.x = pk2(dp[2 * ks][0], dp[2 * ks][1]); pw.y = pk2(dp[2 * ks][2], dp[2 * ks][3]); pw.z = pk2(dp[2 * ks + 1][0], dp[2 * ks + 1][1]); pw.w = pk2(dp[2 * ks + 1][2], dp[2 * ks + 1][3]);
            yp[ks] = __builtin_bit_cast(bf16x8, pw); }
#pragma unroll
        for (int dt = 0; dt < 4; ++dt) {
            dO[dt] = (f32x4){0.f, 0.f, 0.f, 0.f};
            const LAS unsigned char* vrow = L + OFF_VT + (64 * dvh + 16 * dt + fr) * LDW;
            const LAS unsigned char* srow = L + OFF_ST + (64 * dvh + 16 * dt + fr) * LDW;
#pragma unroll
            for (int ks = 0; ks < 2; ++ks) {
                const u32x2 lo = *(const LAS u32x2*)(vrow + (32 * ks + 4 * fq) * 2), hi = *(const LAS u32x2*)(vrow + (32 * ks + 16 + 4 * fq) * 2);
                const bf16x8 xv = __builtin_bit_cast(bf16x8, (v4u){lo.x, lo.y, hi.x, hi.y});
                dO[dt] = __builtin_amdgcn_mfma_f32_16x16x32_bf16(xv, yp[ks], dO[dt], 0, 0, 0);
                const bf16x8 xs = *(const LAS bf16x8*)(srow + (32 * ks + 8 * fq) * 2);
                const bf16x8 y2 = *(const LAS bf16x8*)(L + OFF_Q2 + (16 * it + fr) * LDW + (32 * ks + 8 * fq) * 2);
                dO[dt] = __builtin_amdgcn_mfma_f32_16x16x32_bf16(xs, y2, dO[dt], 0, 0, 0);
            }
        }
    }
    {
        f32x4 dU[4];
#pragma unroll
        for (int nt = 0; nt < 4; ++nt) dU[nt] = (f32x4){0.f, 0.f, 0.f, 0.f};
#pragma unroll
        for (int ks = 0; ks < 2; ++ks) {
            const bf16x8 yv = *(const LAS bf16x8*)(L + OFF_VT + (16 * w + fr) * LDW + (32 * ks + 8 * fq) * 2);
#pragma unroll
            for (int nt = 0; nt < 4; ++nt) { const bf16x8 xk = *(const LAS bf16x8*)(L + OFF_K2T + (16 * nt + fr) * LDW + (32 * ks + 8 * fq) * 2);
                dU[nt] = __builtin_amdgcn_mfma_f32_16x16x32_bf16(xk, yv, dU[nt], 0, 0, 0); }
        }
#pragma unroll
        for (int nt = 0; nt < 4; ++nt) { const f32x4 dc = *(const LAS f32x4*)(L + OFF_DEC + (16 * nt + 4 * fq) * 4); S[nt] = dc * S[nt] + dU[nt]; }
    }
    if (FULL) {
        float ss = 0.f;
#pragma unroll
        for (int dt = 0; dt < 4; ++dt) ss += (dO[dt][0] * dO[dt][0] + dO[dt][1] * dO[dt][1]) + (dO[dt][2] * dO[dt][2] + dO[dt][3] * dO[dt][3]);
        ss += __shfl_xor(ss, 16); ss += __shfl_xor(ss, 32);
        LAS float* SS = (LAS float*)(L + OFF_SS);
        if (fq == 0) SS[dvh * 64 + 16 * it + fr] = ss;
        LDS_WAIT(); __syncthreads();
        const float r = rsqrtf((SS[16 * it + fr] + SS[64 + 16 * it + fr]) * (1.f / 128.f) + EPS);
        const size_t row = row0 + 16 * it + fr;
#pragma unroll
        for (int dt = 0; dt < 4; ++dt) { const int dv0 = 64 * dvh + 16 * dt + 4 * fq;
            const f32x4 g4 = *(const f32x4*)(C.g_out + dv0); const f32x4 sg = ld4(C.SGR + row * 512 + h * 128 + dv0);
            const f32x4 o = dO[dt] * r * g4 * sg;
            u32x2 ow; ow.x = pk2(o[0], o[1]); ow.y = pk2(o[2], o[3]);
            *(u32x2*)(C.OMIX + row * 1024 + h * 128 + dv0) = ow; }
    }
    LDS_WAIT(); __syncthreads();
}

template <bool FULL>
__device__ __forceinline__ void phase(Frame& F, const Ctx& C) {
    const int lane = FLANE, w = F.wave, fr = lane & 15, fq = lane >> 4;
    for (int unit = F.vcu; unit < 256; unit += F.G) {
        const int bh = unit >> 5, seg = unit & 31, b = bh >> 2, h = bh & 3;
        f32x4 S[4];
#pragma unroll
        for (int nt = 0; nt < 4; ++nt) S[nt] = (f32x4){0.f, 0.f, 0.f, 0.f};
        float sumtot = 0.f;
        if (FULL && seg > 0) {
            LAS unsigned char* L = F.lds + RING_OFF;
            LAS float* Dd = (LAS float*)L; LAS float* Wt = (LAS float*)(L + 8192);
            { const int r0 = FTID >> 6, dd = FTID & 63;
#pragma unroll
              for (int j = 0; j < 4; ++j) { const int r = r0 + 8 * j; if (r < seg) Dd[r * 64 + dd] = C.GDEC[(bh * 32 + r) * 64 + dd]; } }
            LDS_WAIT(); __syncthreads();
            if (w == 0) { float wq = 1.f; for (int q = seg - 1; q >= 0; --q) { Wt[q * 64 + lane] = wq; wq *= Dd[q * 64 + lane]; } }
            LDS_WAIT(); __syncthreads();
            for (int q0 = 0; q0 < seg; q0 += 4) {
                f32x4 uu[4][4];
#pragma unroll
                for (int u = 0; u < 4; ++u) { const int q = min(q0 + u, seg - 1);
#pragma unroll
                    for (int nt = 0; nt < 4; ++nt) uu[u][nt] = *(const f32x4*)(C.GST + (size_t)(bh * 32 + q) * 8192 + (16 * w + fr) * 64 + 16 * nt + 4 * fq); }
#pragma unroll
                for (int u = 0; u < 4; ++u) if (q0 + u < seg) {
#pragma unroll
                    for (int nt = 0; nt < 4; ++nt) { const f32x4 wt = *(const LAS f32x4*)(Wt + (q0 + u) * 64 + 16 * nt + 4 * fq); S[nt] = S[nt] + wt * uu[u][nt]; } }
            }
        }
        for (int c = 0; c < 4; ++c) chunk<FULL>(F, C, b, h, (size_t)b * SEQ + seg * 256 + c * 64, S, sumtot);
        if (!FULL) {
#pragma unroll
            for (int nt = 0; nt < 4; ++nt) *(f32x4*)(C.GST + (size_t)unit * 8192 + (16 * w + fr) * 64 + 16 * nt + 4 * fq) = S[nt];
            if (w == 0) C.GDEC[unit * 64 + (FTID & 63)] = __expf(sumtot);
        }
    }
}
}
namespace swa {
typedef short bf16x8 __attribute__((ext_vector_type(8)));
typedef short s16x4 __attribute__((ext_vector_type(4)));
typedef unsigned u32x2 __attribute__((ext_vector_type(2)));
constexpr int KLD = 144, VLD = 528, OFF_K = 0, OFF_VT = 256 * KLD, LDS_END = OFF_VT + 64 * VLD;
static_assert(LDS_END <= RING_BYTES, "swa LDS");

__device__ __forceinline__ void phase(Frame& F, const bf16* SQ, const bf16* SK, const bf16* SV, const float* sinks, bf16* OMIX) {
    LAS unsigned char* L = F.lds + RING_OFF;
    const int tid = FTID, lane = FLANE, w = F.wave, fr = lane & 15, fq = lane >> 4;
    for (int unit = F.vcu; unit < 256; unit += F.G) {
        const int qb = unit & 63, kvh = (unit >> 6) & 1, b = unit >> 7;
        const int t0 = qb * 128, kstart = t0 - 128;
#pragma unroll
        for (int j = 0; j < 4; ++j) {
            const int p = tid + 512 * j, key = p >> 3, ch = p & 7, tok = kstart + key;
            v4u kv = (v4u){0u, 0u, 0u, 0u}, vv = (v4u){0u, 0u, 0u, 0u};
            if (tok >= 0) { const size_t off = ((size_t)b * SEQ + tok) * 128 + kvh * 64 + ch * 8; kv = *(const v4u*)(SK + off); vv = *(const v4u*)(SV + off); }
            *(LAS v4u*)(L + OFF_K + key * KLD + ch * 16) = kv;
            const unsigned vw[4] = {vv.x, vv.y, vv.z, vv.w};
#pragma unroll
            for (int e = 0; e < 8; ++e) *(LAS unsigned short*)(L + OFF_VT + (ch * 8 + e) * VLD + key * 2) = (unsigned short)(vw[e >> 1] >> ((e & 1) * 16));
        }
        LDS_WAIT(); __syncthreads();
        const int hq = 4 * kvh + (w >> 1);
        const float sink2 = sinks[hq] * LOG2E;
        for (int qt = 0; qt < 4; ++qt) {
            const int i0 = (w & 1) * 64 + 16 * qt, T0 = i0 >> 4, i = i0 + fr;
            const size_t qrow = (size_t)b * SEQ + t0 + i;
            bf16x8 yq[2];
#pragma unroll
            for (int ks = 0; ks < 2; ++ks) yq[ks] = *(const bf16x8*)(SQ + qrow * 512 + hq * 64 + 32 * ks + 8 * fq);
            f32x4 ds[10];
#pragma unroll
            for (int nt = 0; nt < 10; ++nt) {
                ds[nt] = (f32x4){0.f, 0.f, 0.f, 0.f};
                const int kt = min(T0 + nt, 15);
#pragma unroll
                for (int ks = 0; ks < 2; ++ks) { const bf16x8 xk = *(const LAS bf16x8*)(L + OFF_K + (16 * kt + fr) * KLD + (32 * ks + 8 * fq) * 2);
                    ds[nt] = __builtin_amdgcn_mfma_f32_16x16x32_bf16(xk, yq[ks], ds[nt], 0, 0, 0); }
            }
            float mx = sink2;
#pragma unroll
            for (int nt = 0; nt < 10; ++nt)
#pragma unroll
                for (int r = 0; r < 4; ++r) { const int kj = 16 * (T0 + nt) + 4 * fq + r;
                    const bool valid = (kj >= i + 1) && (kj <= i + 128) && (kstart + kj >= 0);
                    ds[nt][r] = valid ? ds[nt][r] : -INFINITY; mx = fmaxf(mx, ds[nt][r]); }
            mx = fmaxf(mx, __shfl_xor(mx, 16)); mx = fmaxf(mx, __shfl_xor(mx, 32));
            float l = 0.f;
#pragma unroll
            for (int nt = 0; nt < 10; ++nt)
#pragma unroll
                for (int r = 0; r < 4; ++r) { const float p = exp2f(ds[nt][r] - mx); ds[nt][r] = p; l += p; }
            l += __shfl_xor(l, 16); l += __shfl_xor(l, 32);
            l += exp2f(sink2 - mx);
            const float il = 1.f / l;
            bf16x8 yp[5];
#pragma unroll
            for (int ks = 0; ks < 5; ++ks) { v4u pw; pw.x = pk2(ds[2 * ks][0], ds[2 * ks][1]); pw.y = pk2(ds[2 * ks][2], ds[2 * ks][3]); pw.z = pk2(ds[2 * ks + 1][0], ds[2 * ks + 1][1]); pw.w = pk2(ds[2 * ks + 1][2], ds[2 * ks + 1][3]);
                yp[ks] = __builtin_bit_cast(bf16x8, pw); }
#pragma unroll
            for (int dt = 0; dt < 4; ++dt) {
                f32x4 o = (f32x4){0.f, 0.f, 0.f, 0.f};
                const LAS unsigned char* vrow = L + OFF_VT + (16 * dt + fr) * VLD;
#pragma unroll
                for (int ks = 0; ks < 5; ++ks) {
                    const int ka = min(T0 + 2 * ks, 15), kb = min(T0 + 2 * ks + 1, 15);
                    const u32x2 lo = *(const LAS u32x2*)(vrow + (16 * ka + 4 * fq) * 2), hi = *(const LAS u32x2*)(vrow + (16 * kb + 4 * fq) * 2);
                    const bf16x8 xv = __builtin_bit_cast(bf16x8, (v4u){lo.x, lo.y, hi.x, hi.y});
                    o = __builtin_amdgcn_mfma_f32_16x16x32_bf16(xv, yp[ks], o, 0, 0, 0);
                }
                o = o * il;
                u32x2 ow; ow.x = pk2(o[0], o[1]); ow.y = pk2(o[2], o[3]);
                *(u32x2*)(OMIX + qrow * 1024 + 512 + hq * 64 + 16 * dt + 4 * fq) = ow;
            }
        }
        LDS_WAIT(); __syncthreads();
    }
}
}
struct Args { const void* in[22]; float* out; unsigned char* ws; int ph_lo, ph_hi, li, rep; };
enum { PH_PREP = 0, PH_XN = 1, PH_INPROJ = 2, PH_MIX = 3, PH_MIX2 = 4, PH_OUTPROJ = 5, PH_NORM2 = 6, PH_FFN1 = 7, PH_ROUTE = 8, PH_MOE = 9, PH_FINAL = 10, PH_END = 11 };

__global__ void __launch_bounds__(NTHREADS, 2) mega_fwd(Args args) {
    extern __shared__ __attribute__((aligned(16))) unsigned char lds[];
    Frame F;
    F.lds = (LAS unsigned char*)lds;
    F.MISC = (volatile LAS unsigned*)(F.lds + MISC_OFF);
    F.wave = __builtin_amdgcn_readfirstlane((int)threadIdx.x >> 6);
    F.G = gridDim.x; { const int bx = blockIdx.x; F.vcu = (F.G % 8 == 0) ? (bx % 8) * (F.G / 8) + bx / 8 : bx; }
    F.ws = args.ws; F.ctl = (gu32*)(args.ws + WS_CTL);
    for (int u = (int)threadIdx.x; u < (LDS_BYTES - LDSCTL_OFF) / 4; u += NTHREADS) ((LAS unsigned*)(F.lds + LDSCTL_OFF))[u] = 0u;
    __syncthreads();
    XcdBarrier bar = xcd_barrier_post((unsigned*)(F.ctl + CW_BAR) + args.li * XCD_BAR_WORDS, F.MISC + 8);
    const int lo = args.ph_lo, hi = args.ph_hi;
#define IN(k) (lo <= (k) && (k) < hi)
#define BOTH(k) (IN(k) && IN((k) + 1))
#define SEAM(k) do { if (BOTH(k)) xcd_barrier(bar); } while (0)
    const float* x = (const float*)args.in[0];
    unsigned char* ws = F.ws;
    int* cnt = (int*)(ws + WS_CTL) + CW_CNT; int* list = (int*)(ws + WS_LIST); float* wts = (float*)(ws + WS_WTS);

    if (IN(PH_PREP)) {
        P0In I{(const float*)args.in[1], (const float*)args.in[3], (const float*)args.in[4], (const float*)args.in[6], (const float*)args.in[7], (const float*)args.in[11],
               (const float*)args.in[13], (const float*)args.in[18], (const float*)args.in[19], (const float*)args.in[20], (const int*)args.in[2]};
        p0a_prep(F, I);
        SEAM(PH_PREP);
    }
    if (IN(PH_XN)) {
        mod_finish(F, (const float*)args.in[4]);
        norm_rows(F, x, (const float*)args.in[5], 0, 1024, (bf16*)(ws + WS_XN));
        SEAM(PH_XN);
    }
    if (IN(PH_INPROJ)) {
        pg8::Gemm g{(const pg8::bf16_t*)(ws + WS_XN), (const pg8::bf16_t*)(ws + WS_W1T), M, N1, D};
        pg8::StaticOrder S; S.init(M, N1, F.G, (int)blockIdx.x);
        EpiP1 E{ws, (const float*)args.in[8]};
        pg8::gemm_phase<EpiP1, pg8::StaticOrder, true, true>(F.lds + RING_OFF, g, S, E);
        SEAM(PH_INPROJ);
    }
    const gla::Ctx GC{(const bf16*)(ws + WS_GQ), (const bf16*)(ws + WS_GK), (const bf16*)(ws + WS_GV), (const bf16*)(ws + WS_SGR), (const float*)(ws + WS_LA), (const float*)args.in[9],
                      (float*)(ws + WS_GST), (float*)(ws + WS_GST + 8 * MiB), (bf16*)(ws + WS_OMIX)};
    if (IN(PH_MIX)) {
        gla::phase<false>(F, GC);
        swa::phase(F, (const bf16*)(ws + WS_SQ), (const bf16*)(ws + WS_SK), (const bf16*)(ws + WS_SV), (const float*)args.in[10], (bf16*)(ws + WS_OMIX));
        SEAM(PH_MIX);
    }
    if (IN(PH_MIX2)) {
        gla::phase<true>(F, GC);
        SEAM(PH_MIX2);
    }
    if (IN(PH_OUTPROJ)) {
        pg8::Gemm g{(const pg8::bf16_t*)(ws + WS_OMIX), (const pg8::bf16_t*)(ws + WS_WOT), M, D, D};
        pg8::StaticOrder S; S.init(M, D, F.G, (int)blockIdx.x);
        EpiXmid E{x, (const float*)(ws + WS_MOD), (bf16*)(ws + WS_XMID)};
        pg8::gemm_phase<EpiXmid, pg8::StaticOrder, true, true>(F.lds + RING_OFF, g, S, E);
        SEAM(PH_OUTPROJ);
    }
    if (IN(PH_NORM2)) {
        norm_rows(F, (const bf16*)(ws + WS_XMID), (const float*)args.in[12], 3072, 4096, (bf16*)(ws + WS_H2));
        SEAM(PH_NORM2);
    }
    if (IN(PH_FFN1)) {
        pg8::Gemm g{(const pg8::bf16_t*)(ws + WS_H2), (const pg8::bf16_t*)(ws + WS_W4T), M, 256, D};
        pg8::StaticOrder S; S.init(M, 256, F.G, (int)blockIdx.x);
        EpiP4 E{(float*)(ws + WS_LOGITS)};
        pg8::gemm_phase<EpiP4, pg8::StaticOrder, true, true>(F.lds + RING_OFF, g, S, E);
        SEAM(PH_FFN1);
    }
    if (IN(PH_ROUTE)) {
        route_tokens(F, (const float*)(ws + WS_LOGITS), (const float*)args.in[14], cnt, list, wts);
        SEAM(PH_ROUTE);
    }
    if (IN(PH_MOE)) {
        moe::Ctx C{(const bf16*)(ws + WS_H2), (const float*)args.in[15], (const float*)args.in[16], (const float*)args.in[17], list, wts, (bf16*)(ws + WS_ACT), (bf16*)(ws + WS_SLOTS),
                    (const float*)args.in[18], (const float*)args.in[19], (const float*)args.in[20], (bf16*)(ws + WS_SHOUT)};
        moe::phase(F, C, cnt);
        SEAM(PH_MOE);
    }
    if (IN(PH_FINAL)) {
        final_rows_slots(F, (const bf16*)(ws + WS_XMID), (const bf16*)(ws + WS_SHOUT), (const bf16*)(ws + WS_SLOTS), (const float*)args.in[21], args.out);
    }
#undef IN
#undef BOTH
#undef SEAM
}
constexpr int PROBE_REP = -1;
extern "C" void kernel_launch(void* const* d_in, const int* in_sizes, int n_in, void* d_out, int out_size, void* d_ws, size_t ws_size, hipStream_t stream) {
    static int grid = 0;
    if (grid == 0) {
        if (n_in != 22 || out_size != M * D || ws_size < (size_t)1000 * MiB) { fprintf(stderr, "kernel_launch: unexpected shapes (n_in %d, out %d, ws %zu)\n", n_in, out_size, ws_size); grid = -1; return; }
        int dev = 0, cus = 0, per_cu = 0;
        if (hipGetDevice(&dev) != hipSuccess || hipDeviceGetAttribute(&cus, hipDeviceAttributeMultiprocessorCount, dev) != hipSuccess) { grid = -1; return; }
        if (hipFuncSetAttribute((const void*)mega_fwd, hipFuncAttributeMaxDynamicSharedMemorySize, LDS_BYTES) != hipSuccess) { fprintf(stderr, "kernel_launch: hipFuncSetAttribute failed\n"); grid = -1; return; }
        if (hipOccupancyMaxActiveBlocksPerMultiprocessor(&per_cu, (const void*)mega_fwd, NTHREADS, LDS_BYTES) != hipSuccess || per_cu < 1) fprintf(stderr, "kernel_launch: occupancy query reports %d\n", per_cu);
        (void)hipGetLastError();
        grid = cus;
    }
    if (grid < 0) return;
    unsigned char* ws = (unsigned char*)d_ws;
    (void)hipMemsetAsync(ws + WS_CTL, 0, CTL_ZERO_BYTES, stream);
    Args a{};
    for (int i = 0; i < 22; ++i) a.in[i] = d_in[i];
    a.out = (float*)d_out; a.ws = ws;
    a.ph_lo = 0; a.ph_hi = PH_END; a.li = 0; a.rep = 0;
    hipLaunchKernelGGL(mega_fwd, dim3(grid), dim3(NTHREADS), LDS_BYTES, stream, a);
    if (PROBE_REP >= 0) { a.ph_lo = PROBE_REP; a.ph_hi = PROBE_REP + 1; a.li = 1; hipLaunchKernelGGL(mega_fwd, dim3(grid), dim3(NTHREADS), LDS_BYTES, stream, a); }
}
```
